# Optimizing an MI355X kernel written in HIP

```python
import math
import jax, jax.numpy as jnp
from jax import lax
import numpy as np

D_MODEL = 2048
BATCH = 4
SEQ = 8192
DEPTH = 4

ATTN_WIDTH = D_MODEL // 2
HEAD_DIM = 64
N_ATTN_HEADS = ATTN_WIDTH // HEAD_DIM
ATTN_PATTERNS = ((128, 1), (512, 4), (2048, 16))
SSM_WIDTH = D_MODEL - ATTN_WIDTH
SSM_GROUP = 16
SSM_STATE = 64
N_SSM_GROUPS = SSM_WIDTH // SSM_GROUP
IN_WIDTH = 3 * ATTN_WIDTH + SSM_WIDTH
D_FF = 4 * D_MODEL
DEEPNORM_ALPHA = (2 * DEPTH) ** 0.25
DEEPNORM_BETA = (8 * DEPTH) ** -0.25
LN_EPS = 1e-5
NEG_BIG = -1e30
STEP_MIN = 1e-3
STEP_MAX = 1e-1

kernel_name = 'hymba_s5_longnet_deepnorm_encoder'


def _layer_norm(x, g, b):
    xf = x.astype(jnp.float32)
    mu = xf.mean(-1, keepdims=True)
    var = jnp.square(xf - mu).mean(-1, keepdims=True)
    y = (xf - mu) * lax.rsqrt(var + LN_EPS) * g.astype(jnp.float32) + b.astype(jnp.float32)
    return y.astype(x.dtype)


def _rms_norm(x, g):
    xf = x.astype(jnp.float32)
    y = xf * lax.rsqrt(jnp.square(xf).mean(-1, keepdims=True) + LN_EPS) * g.astype(jnp.float32)
    return y.astype(x.dtype)


def _alibi_slopes(n_heads):
    return jnp.exp2(-8.0 * jnp.arange(1, n_heads + 1, dtype=jnp.float32) / n_heads)


def _dilated_band_attention(q, k, v, window, dilation):
    bsz, nh, seq, hd = q.shape
    half = window // (2 * dilation)
    length = seq // dilation
    nb = -(-length // half)
    lp = nb * half

    def strided(t):
        return t.reshape(bsz, nh, length, dilation, hd).transpose(0, 1, 3, 2, 4)

    qs, ks, vs = strided(q), strided(k), strided(v)
    qb = jnp.pad(qs, ((0, 0), (0, 0), (0, 0), (0, lp - length), (0, 0))).reshape(
        bsz, nh, dilation, nb, half, hd)

    def band(t):
        tp = jnp.pad(t, ((0, 0), (0, 0), (0, 0), (half, lp - length + half), (0, 0))).reshape(
            bsz, nh, dilation, nb + 2, half, hd)
        return jnp.concatenate([tp[:, :, :, 0:nb], tp[:, :, :, 1:nb + 1], tp[:, :, :, 2:nb + 2]], axis=-2)

    kb, vb = band(ks), band(vs)
    q_pos = jnp.arange(nb)[:, None] * half + jnp.arange(half)[None, :]
    k_pos = jnp.arange(nb)[:, None] * half - half + jnp.arange(3 * half)[None, :]
    rel = jnp.abs(k_pos[:, None, :] - q_pos[:, :, None])
    valid = (rel <= half) & (k_pos[:, None, :] >= 0) & (k_pos[:, None, :] < length)
    slopes = _alibi_slopes(nh)
    bias = -slopes[:, None, None, None, None] * (rel * dilation).astype(jnp.float32)

    scores = jnp.einsum('bhrnqd,bhrnkd->bhrnqk', qb, kb).astype(jnp.float32) * (hd ** -0.5) + bias
    scores = jnp.where(valid, scores, NEG_BIG)
    m = scores.max(-1, keepdims=True)
    p = jnp.exp(scores - m)
    den = p.sum(-1)
    out = jnp.einsum('bhrnqk,bhrnkd->bhrnqd', p, vb.astype(jnp.float32)) / den[..., None]
    lse = m[..., 0] + jnp.log(den)
    out = out.reshape(bsz, nh, dilation, lp, hd)[:, :, :, :length].transpose(0, 1, 3, 2, 4)
    lse = lse.reshape(bsz, nh, dilation, lp)[..., :length].transpose(0, 1, 3, 2)
    return out.reshape(bsz, nh, seq, hd), lse.reshape(bsz, nh, seq)


def _dilated_mixture_attention(q, k, v):
    outs, lses = [], []
    for window, dilation in ATTN_PATTERNS:
        o, l = _dilated_band_attention(q, k, v, window, dilation)
        outs.append(o)
        lses.append(l)
    w = jax.nn.softmax(jnp.stack(lses), axis=0)
    return jnp.einsum('pbhs,pbhsd->bhsd', w, jnp.stack(outs))


def _complex_affine_combine(e1, e2):
    a1r, a1i, b1r, b1i = e1
    a2r, a2i, b2r, b2i = e2
    return (a1r * a2r - a1i * a2i,
            a1r * a2i + a1i * a2r,
            a2r * b1r - a2i * b1i + b2r,
            a2r * b1i + a2i * b1r + b2i)


def _s5_bidirectional(u, lam_re, lam_im, log_step, b_re, b_im, c_re, c_im, d_skip):
    bsz, seq, _ = u.shape
    f32 = jnp.float32
    ug = u.reshape(bsz, seq, N_SSM_GROUPS, SSM_GROUP).astype(f32)
    y = ug * d_skip.reshape(N_SSM_GROUPS, SSM_GROUP).astype(f32)
    for direction in range(2):
        step = jnp.exp(log_step[direction].astype(f32))[:, None]
        lr, li = lam_re[direction].astype(f32), lam_im[direction].astype(f32)
        mag = jnp.exp(lr * step)
        a_re, a_im = mag * jnp.cos(li * step), mag * jnp.sin(li * step)
        den = lr * lr + li * li
        coef_re = ((a_re - 1.0) * lr + a_im * li) / den
        coef_im = (a_im * lr - (a_re - 1.0) * li) / den
        br, bi = b_re[direction].astype(f32), b_im[direction].astype(f32)
        bb_re = coef_re[..., None] * br - coef_im[..., None] * bi
        bb_im = coef_re[..., None] * bi + coef_im[..., None] * br
        bu_re = jnp.einsum('bsgc,gpc->bsgp', ug, bb_re)
        bu_im = jnp.einsum('bsgc,gpc->bsgp', ug, bb_im)
        shape = bu_re.shape
        elems = (jnp.broadcast_to(a_re, shape), jnp.broadcast_to(a_im, shape), bu_re, bu_im)
        _, _, x_re, x_im = lax.associative_scan(_complex_affine_combine, elems,
                                                reverse=(direction == 1), axis=1)
        y = (y + jnp.einsum('bsgp,gcp->bsgc', x_re, c_re[direction].astype(f32))
             - jnp.einsum('bsgp,gcp->bsgc', x_im, c_im[direction].astype(f32)))
    return y.reshape(bsz, seq, SSM_WIDTH).astype(u.dtype)


def _hybrid_mixer(h, w_in, lam_re, lam_im, log_step, b_re, b_im, c_re, c_im, d_skip,
                  w_glu, b_glu, g_attn, g_ssm, w_out):
    bsz, seq, _ = h.shape
    proj = h @ w_in
    q = proj[..., :ATTN_WIDTH]
    k = proj[..., ATTN_WIDTH:2 * ATTN_WIDTH]
    v = proj[..., 2 * ATTN_WIDTH:3 * ATTN_WIDTH]
    u = proj[..., 3 * ATTN_WIDTH:]

    def heads(t):
        return t.reshape(bsz, seq, N_ATTN_HEADS, HEAD_DIM).transpose(0, 2, 1, 3)

    attn = _dilated_mixture_attention(heads(q), heads(k), heads(v))
    attn = attn.transpose(0, 2, 1, 3).reshape(bsz, seq, ATTN_WIDTH).astype(h.dtype)

    ssm = jax.nn.gelu(_s5_bidirectional(u, lam_re, lam_im, log_step, b_re, b_im, c_re, c_im, d_skip))
    ssm = ssm * jax.nn.sigmoid(ssm @ w_glu + b_glu)

    merged = jnp.concatenate([_rms_norm(attn, g_attn), _rms_norm(ssm, g_ssm)], axis=-1)
    return merged @ w_out


def setup_inputs(seed: int = 0) -> dict:
    key = jax.random.key(seed)
    ks = jax.random.split(key, 24)
    f32 = jnp.float32

    def nrm(k, shape, s):
        return s * jax.random.normal(k, shape, f32)

    lam_shape = (DEPTH, 2, N_SSM_GROUPS, SSM_STATE)
    return {
        'x': nrm(ks[0], (BATCH, SEQ, D_MODEL), 1.0),
        'c': nrm(ks[1], (BATCH, D_MODEL), 1.0),
        'w_ada': nrm(ks[2], (DEPTH, D_MODEL, 6 * D_MODEL), 0.1 * D_MODEL ** -0.5),
        'b_ada': nrm(ks[3], (DEPTH, 6 * D_MODEL), 0.01),
        'w_in': nrm(ks[4], (DEPTH, D_MODEL, IN_WIDTH), D_MODEL ** -0.5),
        'ssm_lam_re': -0.5 * jnp.exp(nrm(ks[5], lam_shape, 0.05)),
        'ssm_lam_im': jnp.pi * jnp.arange(SSM_STATE, dtype=f32) + nrm(ks[6], lam_shape, 0.01),
        'ssm_log_step': jax.random.uniform(ks[7], (DEPTH, 2, N_SSM_GROUPS), f32,
                                           math.log(STEP_MIN), math.log(STEP_MAX)),
        'ssm_b_re': nrm(ks[8], (DEPTH, 2, N_SSM_GROUPS, SSM_STATE, SSM_GROUP), 0.5),
        'ssm_b_im': nrm(ks[9], (DEPTH, 2, N_SSM_GROUPS, SSM_STATE, SSM_GROUP), 0.5),
        'ssm_c_re': nrm(ks[10], (DEPTH, 2, N_SSM_GROUPS, SSM_GROUP, SSM_STATE), (2 * SSM_STATE) ** -0.5),
        'ssm_c_im': nrm(ks[11], (DEPTH, 2, N_SSM_GROUPS, SSM_GROUP, SSM_STATE), (2 * SSM_STATE) ** -0.5),
        'ssm_d': nrm(ks[12], (DEPTH, SSM_WIDTH), 1.0),
        'w_glu': nrm(ks[13], (DEPTH, SSM_WIDTH, SSM_WIDTH), SSM_WIDTH ** -0.5),
        'b_glu': nrm(ks[14], (DEPTH, SSM_WIDTH), 0.01),
        'g_attn': 1.0 + nrm(ks[15], (DEPTH, ATTN_WIDTH), 0.02),
        'g_ssm': 1.0 + nrm(ks[16], (DEPTH, SSM_WIDTH), 0.02),
        'w_out': nrm(ks[17], (DEPTH, D_MODEL, D_MODEL), DEEPNORM_BETA * D_MODEL ** -0.5),
        'ln1_g': 1.0 + nrm(ks[18], (DEPTH, D_MODEL), 0.02),
        'ln1_b': nrm(ks[19], (DEPTH, D_MODEL), 0.02),
        'w_mlp1': nrm(ks[20], (DEPTH, D_MODEL, D_FF), D_MODEL ** -0.5),
        'w_mlp2': nrm(ks[21], (DEPTH, D_FF, D_MODEL), DEEPNORM_BETA * D_FF ** -0.5),
        'ln2_g': 1.0 + nrm(ks[22], (DEPTH, D_MODEL), 0.02),
        'ln2_b': nrm(ks[23], (DEPTH, D_MODEL), 0.02),
    }


def reference(x, c, w_ada, b_ada, w_in, ssm_lam_re, ssm_lam_im, ssm_log_step, ssm_b_re, ssm_b_im,
              ssm_c_re, ssm_c_im, ssm_d, w_glu, b_glu, g_attn, g_ssm, w_out, ln1_g, ln1_b,
              w_mlp1, w_mlp2, ln2_g, ln2_b):
    cond = jax.nn.silu(c)
    for layer in range(DEPTH):
        mods = cond @ w_ada[layer] + b_ada[layer]
        sh1, sc1, g1, sh2, sc2, g2 = jnp.split(mods[:, None, :], 6, axis=-1)
        h = x * (1.0 + sc1) + sh1
        mix = _hybrid_mixer(h, w_in[layer], ssm_lam_re[layer], ssm_lam_im[layer], ssm_log_step[layer],
                            ssm_b_re[layer], ssm_b_im[layer], ssm_c_re[layer], ssm_c_im[layer],
                            ssm_d[layer], w_glu[layer], b_glu[layer], g_attn[layer], g_ssm[layer],
                            w_out[layer])
        x = _layer_norm(DEEPNORM_ALPHA * x + (1.0 + g1) * mix, ln1_g[layer], ln1_b[layer])
        h = x * (1.0 + sc2) + sh2
        ff = jnp.square(jax.nn.relu(h @ w_mlp1[layer])) @ w_mlp2[layer]
        x = _layer_norm(DEEPNORM_ALPHA * x + (1.0 + g2) * ff, ln2_g[layer], ln2_b[layer])
    return x
```

```cpp
#include <hip/hip_runtime.h>
#include <cstdio>
#include <cstdint>
#define GAS __attribute__((address_space(1)))
typedef const __attribute__((address_space(4))) unsigned long long* kargp_t;
__device__ __forceinline__ kargp_t karg() { kargp_t kp = (kargp_t)__builtin_amdgcn_kernarg_segment_ptr(); asm volatile("" : "+s"(kp)); return kp; }
__device__ __forceinline__ const float* IN(int i) { return (const float*)(const GAS float*)karg()[i]; }
__device__ __forceinline__ float* OUTP() { return (float*)(GAS float*)karg()[24]; }
__device__ __forceinline__ unsigned char* WSP() { return (unsigned char*)(GAS unsigned char*)karg()[25]; }
#define WSB(T, off) ((T*)(WSP() + (off)))
namespace pg8 {
#define PG8_LAS __attribute__((address_space(3)))
typedef unsigned short bf16_t;
typedef short bf16x8 __attribute__((ext_vector_type(8)));
typedef float f32x4 __attribute__((ext_vector_type(4)));
typedef unsigned u32x4 __attribute__((ext_vector_type(4)));
constexpr int BM = 256, BK = 64, HALF = 128, HTB = HALF * BK * 2  , STAGE_BYTES = 8 * HTB, NXCD = 8;

__host__ __device__ __forceinline__ int lds_byte(int r, int c) { const int st = (r >> 4) * 2 + (c >> 5), rr = r & 15, cc = c & 31, ob = rr * 64 + cc * 2; return st * 1024 + (ob ^ (((ob >> 9) & 1) << 5)); }
__host__ __device__ __forceinline__ void stage_rc(int b, int& R, int& C) { const int st = b / 1024, sb = b % 1024, swz = sb ^ (((sb >> 9) & 1) << 5); R = (st >> 1) * 16 + swz / 64; C = (st & 1) * 32 + (swz % 64) / 2; }
__host__ __device__ __forceinline__ int perm32(int rho) { const int n = rho >> 4, i = rho & 15; return 8 * (i >> 2) + 4 * n + (i & 3); }

struct Unit { int pm, pn; };
struct Gemm { const bf16_t* A; const bf16_t* Bt; int K; int ars, aks, ldb; };
__host__ __device__ __forceinline__ Gemm gemm_rm(const bf16_t* A, const bf16_t* Bt, int K) { return Gemm{A, Bt, K, K, 16, K}; }

struct StaticOrder {
    int nM, nN, nwg, G, c, WGM;
    __host__ __device__ void init(int M, int N, int G_, int c_, int wgm = 4) { nM = M / BM; nN = N / BM; nwg = nM * nN; G = G_; c = c_; WGM = wgm; }
    __host__ __device__ bool next(int i, Unit& u) const {
        const long L = (long)i * G + c; if (L >= nwg) return false;
        int wgid = (int)L; { const int q = nwg / NXCD, r = nwg % NXCD, xcd = wgid % NXCD, off = wgid / NXCD; wgid = (xcd < r ? xcd * (q + 1) : r * (q + 1) + (xcd - r) * q) + off; }
        const int nig = WGM * nN, gid = wgid / nig, fm = gid * WGM, gsz = (nM - fm) < WGM ? (nM - fm) : WGM;
        u.pm = fm + ((wgid % nig) % gsz); u.pn = (wgid % nig) / gsz; return true;
    }
    __device__ __forceinline__ void a_ready(const Unit&) const {}
    __device__ __forceinline__ void done(const Unit&) const {}
};

__device__ __forceinline__ unsigned cvt_pk_bf16(float lo, float hi) { unsigned r; asm volatile("v_cvt_pk_bf16_f32 %0, %1, %2" : "=v"(r) : "v"(lo), "v"(hi)); return r; }
typedef float f32x2 __attribute__((ext_vector_type(2)));
template <int ACT> struct EpiBf16 {
    static constexpr bool PERM = true, AFTER_DRAIN = false; static constexpr bool MIDK = false;
    bf16_t* O; int ldc; int split_cols; size_t split_stride; float scale0;
    __device__ __forceinline__ void operator()(const f32x4 (&acc)[2][2][4][2], const Unit& u, int wr, int wc, int fr, int fq) const {
        const int row0 = u.pm * BM + wr * 64 + fr; int colt = u.pn * BM; bf16_t* base = O;
        float sc = 1.f; if (split_cols) { const int t = colt / split_cols; base += (size_t)t * split_stride; colt -= t * split_cols; if (t == 0) sc = scale0; }
        const int col0 = colt + wc * 32 + 8 * fq;
#pragma unroll
        for (int ai = 0; ai < 2; ++ai)
#pragma unroll
            for (int m = 0; m < 4; ++m) { bf16_t* rowp = base + (size_t)(row0 + ai * HALF + m * 16) * ldc + col0;
#pragma unroll
                for (int bj = 0; bj < 2; ++bj) { f32x4 v0 = acc[ai][bj][m][0], v1 = acc[ai][bj][m][1];
                    if (ACT == 2) {
#pragma unroll
                        for (int e = 0; e < 4; ++e) { const float a = fmaxf(v0[e], 0.f), b = fmaxf(v1[e], 0.f); v0[e] = a * a; v1[e] = b * b; } }
                    v0 = v0 * sc; v1 = v1 * sc; u32x4 w; w.x = cvt_pk_bf16(v0[0], v0[1]); w.y = cvt_pk_bf16(v0[2], v0[3]); w.z = cvt_pk_bf16(v1[0], v1[1]); w.w = cvt_pk_bf16(v1[2], v1[3]);
                    *(u32x4*)(rowp + bj * HALF) = w; } }
    }
};
__device__ __forceinline__ float bf_lo(unsigned w) { return __uint_as_float(w << 16); }
__device__ __forceinline__ float bf_hi(unsigned w) { return __uint_as_float(w & 0xffff0000u); }
typedef _Float16 f16x8 __attribute__((ext_vector_type(8)));
__device__ __forceinline__ u32x4 pack_f16x8(const f32x4& a, const f32x4& b) { f16x8 h = {(_Float16)a[0], (_Float16)a[1], (_Float16)a[2], (_Float16)a[3], (_Float16)b[0], (_Float16)b[1], (_Float16)b[2], (_Float16)b[3]}; return __builtin_bit_cast(u32x4, h); }
__device__ __forceinline__ void unpack_f16x8(const u32x4& w, f32x4& a, f32x4& b) { const f16x8 h = __builtin_bit_cast(f16x8, w); a = (f32x4){(float)h[0], (float)h[1], (float)h[2], (float)h[3]}; b = (f32x4){(float)h[4], (float)h[5], (float)h[6], (float)h[7]}; }
template <bool MIX> struct EpiResidT {
    static constexpr bool PERM = true, AFTER_DRAIN = false; static constexpr bool MIDK = MIX;
    int l, sub;
    size_t mods_off, stats_off, yb_off, ssq_off; int ldc, gstride, rows_per_batch; float alpha;
    size_t cnt_off;
    PG8_LAS unsigned char* gtab;
    __device__ __forceinline__ void midk(f32x4 (&acc)[2][2][4][2], const Unit& u, int wr, int wc, int fr, int fq) const {
        const f32x2* rf = (const f32x2*)(WSP() + ssq_off); const int row0 = u.pm * BM + wr * 64 + fr;
        float ratio[8];
#pragma unroll
        for (int i = 0; i < 8; ++i) ratio[i] = rf[row0 + (i >> 2) * HALF + (i & 3) * 16].x;
#pragma unroll
        for (int i = 0; i < 8; ++i)
#pragma unroll
            for (int bj = 0; bj < 2; ++bj)
#pragma unroll
                for (int n = 0; n < 2; ++n) acc[i >> 2][bj][i & 3][n] = acc[i >> 2][bj][i & 3][n] * ratio[i];
    }
    __device__ __forceinline__ void gain_table(const Unit& u) const {
        int tid = threadIdx.x; asm volatile("" : "+v"(tid));
        const int w = __builtin_amdgcn_readfirstlane(tid >> 6), lane = tid & 63;
        if (w < 3) {
            const int b = (u.pm * BM) / rows_per_batch; const int ll = sub == 0 ? (l > 0 ? l - 1 : 0) : l;
            const float* src = w == 0 ? (const float*)(WSP() + mods_off) + (size_t)l * 4 * gstride + (sub == 0 ? 2 : 5) * ldc + (size_t)b * gstride
                             : (w == 1 ? IN(sub == 0 ? 22 : 18) + (size_t)ll * ldc : IN(sub == 0 ? 23 : 19) + (size_t)ll * ldc);
            __builtin_amdgcn_global_load_lds((const unsigned*)(src + u.pn * BM + 4 * lane), (PG8_LAS unsigned*)(gtab + w * 1024), 16, 0, 0);
        }
    }
    __device__ __forceinline__ void count_in(const Unit& u) const {
        if (threadIdx.x == 0) __hip_atomic_fetch_add((GAS unsigned*)(WSP() + cnt_off) + (l * 2 + sub) * 128 + u.pm, 1u, __ATOMIC_RELAXED, __HIP_MEMORY_SCOPE_AGENT); }
    __device__ __forceinline__ void operator()(const f32x4 (&acc)[2][2][4][2], const Unit& u, int wr, int wc, int fr, int fq) const {
        const int row0 = u.pm * BM + wr * 64 + fr, col0 = u.pn * BM + wc * 32 + 8 * fq;
        const int b = (u.pm * BM) / rows_per_batch;
        const bool first = (l == 0 && sub == 0);
        bf16_t* YB = (bf16_t*)(WSP() + yb_off);
        const float* gate = (const float*)(WSP() + mods_off) + (size_t)l * 4 * gstride + (sub == 0 ? 2 : 5) * ldc;
        const float* stats = (const float*)(WSP() + stats_off);
        const int ll = sub == 0 ? (l > 0 ? l - 1 : 0) : l;
        const float* lg = IN(sub == 0 ? 22 : 18) + (size_t)ll * ldc; const float* lb = IN(sub == 0 ? 23 : 19) + (size_t)ll * ldc;
        const PG8_LAS float* tb = (const PG8_LAS float*)(gtab) + (wc * 32 + 8 * fq);
        constexpr int NL = MIX ? 8 : 6, NS = 4;
        const f32x2* rfp = (const f32x2*)(WSP() + ssq_off);
        u32x4 wq[2][2][2]; f32x2 stq[2][2]; f32x2 rfq[2][2];
#define EPI_ISSUE(aq_, buf_) do { _Pragma("unroll") for (int mm = 0; mm < 2; ++mm) { const int r_ = row0 + ((aq_) >> 1) * HALF + (((aq_) & 1) * 2 + mm) * 16; \
            const bf16_t* p_ = YB + (size_t)r_ * ldc + col0; const float* sp2_ = stats + 2 * (size_t)r_; \
            asm volatile("global_load_dwordx4 %0, %1, off" : "=&v"(wq[buf_][mm][0]) : "v"(p_) : "memory"); \
            asm volatile("global_load_dwordx4 %0, %1, off offset:256" : "=&v"(wq[buf_][mm][1]) : "v"(p_) : "memory"); \
            asm volatile("global_load_dwordx2 %0, %1, off" : "=&v"(stq[buf_][mm]) : "v"(sp2_) : "memory"); \
            if constexpr (MIX) { const f32x2* rp_ = rfp + r_; asm volatile("global_load_dwordx2 %0, %1, off" : "=&v"(rfq[buf_][mm]) : "v"(rp_) : "memory"); } } } while (0)
#define EPI_WAIT(n_, buf_) do { if constexpr (MIX) asm volatile("s_waitcnt vmcnt(%8)" : "+v"(wq[buf_][0][0]), "+v"(wq[buf_][0][1]), "+v"(wq[buf_][1][0]), "+v"(wq[buf_][1][1]), "+v"(stq[buf_][0]), "+v"(stq[buf_][1]), "+v"(rfq[buf_][0]), "+v"(rfq[buf_][1]) : "n"(n_) : "memory"); \
            else asm volatile("s_waitcnt vmcnt(%6)" : "+v"(wq[buf_][0][0]), "+v"(wq[buf_][0][1]), "+v"(wq[buf_][1][0]), "+v"(wq[buf_][1][1]), "+v"(stq[buf_][0]), "+v"(stq[buf_][1]) : "n"(n_) : "memory"); } while (0)
        EPI_ISSUE(0, 0); EPI_ISSUE(1, 1);
#pragma unroll
        for (int aq = 0; aq < 4; ++aq) { const int ai = aq >> 1, mb_ = (aq & 1) * 2, cb = aq & 1;
            if (aq == 0) { if (cb == 0) EPI_WAIT(NL, 0); } else if (aq == 3) { EPI_WAIT(NS, 1); } else { if (cb == 0) EPI_WAIT(NS + NL, 0); else EPI_WAIT(NS + NL, 1); }
#pragma unroll
            for (int mm = 0; mm < 2; ++mm) { const int m = mb_ + mm; const int r = row0 + ai * HALF + m * 16; const size_t off = (size_t)r * ldc + col0;
                const float mean = first ? 0.f : stq[cb][mm].x, rstd = first ? 1.f : stq[cb][mm].y; float rsm = 1.f; if constexpr (MIX) rsm = rfq[cb][mm].y;
#pragma unroll
                for (int bj = 0; bj < 2; ++bj) { f32x4 xv[2], y[2]; unpack_f16x8(wq[cb][mm][bj], xv[0], xv[1]);
#pragma unroll
                    for (int n = 0; n < 2; ++n) { const f32x4 gv_ = *(const PG8_LAS f32x4*)(tb + bj * HALF + n * 4) + 1.0f;
                        f32x4 gm_ = {alpha, alpha, alpha, alpha}, bt_ = {0.f, 0.f, 0.f, 0.f};
                        if (!first) { gm_ = *(const PG8_LAS f32x4*)(tb + 256 + bj * HALF + n * 4) * alpha; bt_ = *(const PG8_LAS f32x4*)(tb + 512 + bj * HALF + n * 4) * alpha; }
                        y[n] = ((xv[n] - mean) * rstd) * gm_ + bt_ + gv_ * (acc[ai][bj][m][n] * rsm); }
                    { const u32x4 pk_ = pack_f16x8(y[0], y[1]); bf16_t* sp_ = YB + off + bj * HALF;
                      asm volatile("global_store_dwordx4 %0, %1, off sc1\n\ts_nop 1" :: "v"(sp_), "v"(pk_) : "memory"); } } }
            if (aq + 2 < 4) { if (cb == 0) EPI_ISSUE(aq + 2, 0); else EPI_ISSUE(aq + 2, 1); } }
#undef EPI_ISSUE
#undef EPI_WAIT
    }
};

template <class E> struct has_cnt { static constexpr bool v = false; };
template <bool MIX> struct has_cnt<EpiResidT<MIX>> { static constexpr bool v = true; };
template <class E> struct has_gtab { static constexpr bool v = false; };
template <bool MIX> struct has_gtab<EpiResidT<MIX>> { static constexpr bool v = true; };

struct EpiQKVU {
    static constexpr bool PERM = true, AFTER_DRAIN = false; static constexpr bool MIDK = false;
    bf16_t* O; size_t split_stride; float scale0; bf16_t* UX; int nchunk;
    __device__ __forceinline__ void operator()(const f32x4 (&acc)[2][2][4][2], const Unit& u, int wr, int wc, int fr, int fq) const {
        const int row0 = u.pm * BM + wr * 64 + fr; const int t = (u.pn * BM) >> 10; const int colt = (u.pn * BM) & 1023;
        const float sc = (t == 0) ? scale0 : 1.f;
        const int col0 = colt + wc * 32 + 8 * fq;
#pragma unroll
        for (int ai = 0; ai < 2; ++ai)
#pragma unroll
            for (int m = 0; m < 4; ++m) { const int r = row0 + ai * HALF + m * 16;
#pragma unroll
                for (int bj = 0; bj < 2; ++bj) { f32x4 v0 = acc[ai][bj][m][0] * sc, v1 = acc[ai][bj][m][1] * sc;
                    u32x4 w; w.x = cvt_pk_bf16(v0[0], v0[1]); w.y = cvt_pk_bf16(v0[2], v0[3]); w.z = cvt_pk_bf16(v1[0], v1[1]); w.w = cvt_pk_bf16(v1[2], v1[3]);
                    const int col = col0 + bj * HALF;
                    bf16_t* p = (t == 0) ? O + (size_t)r * 1024 + col
                              : (t < 3) ? O + (size_t)t * split_stride + ((size_t)(col >> 6) * (split_stride >> 10) + r) * 64 + (col & 63)
                                        : UX + ((size_t)(col >> 4) * nchunk + (r >> 5)) * 768 + (r & 31) * 16 + (col & 15);
                    *(u32x4*)p = w; } }
    }
};
struct EpiStateF32 {
    static constexpr bool PERM = false, AFTER_DRAIN = false; static constexpr bool MIDK = false;
    float* C;
    __device__ __forceinline__ void operator()(const f32x4 (&acc)[2][2][4][2], const Unit& u, int wr, int wc, int fr, int fq) const {
        const int row0 = u.pm * BM + wr * 64 + fr, col0 = wc * 32 + 4 * fq;
#pragma unroll
        for (int ai = 0; ai < 2; ++ai)
#pragma unroll
            for (int m = 0; m < 4; ++m) { float* rowp = C + (size_t)(row0 + ai * HALF + m * 16) * 256 + col0;
#pragma unroll
                for (int bj = 0; bj < 2; ++bj)
#pragma unroll
                    for (int n = 0; n < 2; ++n) *(f32x4*)(rowp + bj * HALF + n * 16) = acc[ai][bj][m][n]; }
    }
};
__device__ __forceinline__ float gelu_tanh_f(float x) { const float z = 0.7978845608028654f * (x + 0.044715f * x * x * x); return x * __builtin_amdgcn_rcpf(1.f + __expf(-2.f * z)); }
struct EpiSsmY {
    static constexpr bool PERM = true, AFTER_DRAIN = false; static constexpr bool MIDK = false;
    bf16_t* O;
    __device__ __forceinline__ void operator()(const f32x4 (&acc)[2][2][4][2], const Unit& u, int wr, int wc, int fr, int fq) const {
        const int row0 = u.pm * BM + wr * 64 + fr, col0 = (u.pn & 1) * BM + wc * 32 + 8 * fq;
#pragma unroll
        for (int ai = 0; ai < 2; ++ai)
#pragma unroll
            for (int m = 0; m < 4; ++m) { bf16_t* rowp = O + (size_t)(row0 + ai * HALF + m * 16) * 512 + col0;
#pragma unroll
                for (int bj = 0; bj < 2; ++bj) { const f32x4 v0 = acc[ai][bj][m][0], v1 = acc[ai][bj][m][1];
                    u32x4 w; w.x = cvt_pk_bf16(gelu_tanh_f(v0[0]), gelu_tanh_f(v0[1])); w.y = cvt_pk_bf16(gelu_tanh_f(v0[2]), gelu_tanh_f(v0[3]));
                    w.z = cvt_pk_bf16(gelu_tanh_f(v1[0]), gelu_tanh_f(v1[1])); w.w = cvt_pk_bf16(gelu_tanh_f(v1[2]), gelu_tanh_f(v1[3]));
                    *(u32x4*)(rowp + bj * HALF) = w; } }
    }
};
struct EpiGluG {
    static constexpr bool PERM = true, AFTER_DRAIN = false; static constexpr bool MIDK = false;
    const bf16_t* S; size_t gstride; bf16_t* O; int ldo; int ocol; const float* bias; float* ssq;
    __device__ __forceinline__ void operator()(const f32x4 (&acc)[2][2][4][2], const Unit& u, int wr, int wc, int fr, int fq) const {
        const int row0 = u.pm * BM + wr * 64 + fr; const int col0 = u.pn * BM + wc * 32 + 8 * fq;
        f32x4 bv[2][2];
#pragma unroll
        for (int bj = 0; bj < 2; ++bj)
#pragma unroll
            for (int n = 0; n < 2; ++n) bv[bj][n] = *(const f32x4*)(bias + col0 + bj * HALF + 4 * n);
        const bf16_t* __restrict__ Sr = S; bf16_t* __restrict__ Or = O;
#pragma unroll
        for (int ai = 0; ai < 2; ++ai) {
            u32x4 sv[4][2]; float sq[4] = {0.f, 0.f, 0.f, 0.f};
#pragma unroll
            for (int m = 0; m < 4; ++m) { const size_t r = (size_t)(row0 + ai * HALF + m * 16);
#pragma unroll
                for (int bj = 0; bj < 2; ++bj) { const int col = col0 + bj * HALF; sv[m][bj] = *(const u32x4*)(Sr + (size_t)(col >> 4) * gstride + r * 16 + (col & 15)); } }
#pragma unroll
            for (int m = 0; m < 4; ++m) { const size_t r = (size_t)(row0 + ai * HALF + m * 16);
#pragma unroll
                for (int bj = 0; bj < 2; ++bj) { const f32x4 z0 = acc[ai][bj][m][0] + bv[bj][0], z1 = acc[ai][bj][m][1] + bv[bj][1];
                    const int col = col0 + bj * HALF; const u32x4 w_ = sv[m][bj];
                    float s[8] = {bf_lo(w_.x), bf_hi(w_.x), bf_lo(w_.y), bf_hi(w_.y), bf_lo(w_.z), bf_hi(w_.z), bf_lo(w_.w), bf_hi(w_.w)};
                    float o[8];
#pragma unroll
                    for (int e = 0; e < 4; ++e) { o[e] = s[e] * __builtin_amdgcn_rcpf(1.f + __expf(-z0[e])); o[4 + e] = s[4 + e] * __builtin_amdgcn_rcpf(1.f + __expf(-z1[e])); }
                    u32x4 w; w.x = cvt_pk_bf16(o[0], o[1]); w.y = cvt_pk_bf16(o[2], o[3]); w.z = cvt_pk_bf16(o[4], o[5]); w.w = cvt_pk_bf16(o[6], o[7]);
#pragma unroll
                    for (int e2 = 0; e2 < 8; ++e2) sq[m] += o[e2] * o[e2];
                    *(u32x4*)(Or + r * ldo + ocol + col) = w; } }
#pragma unroll
            for (int m = 0; m < 4; ++m) { float q = sq[m]; q += __shfl_xor(q, 16); q += __shfl_xor(q, 32);
                if (fq == 0) ssq[(size_t)(row0 + ai * HALF + m * 16) * 16 + 4 * u.pn + wc] = q; }
            asm volatile("" ::: "memory"); }
    }
};
struct GroupOrder {
    int nMg, nNg, nwg, G, c;
    __host__ __device__ void init(int ngroups, int nMg_, int nNg_, int G_, int c_) { nMg = nMg_; nNg = nNg_; nwg = ngroups * nMg_ * nNg_; G = G_; c = c_; }
    __host__ __device__ bool next(int i, Unit& u) const {
        const long L = (long)i * G + c; if (L >= nwg) return false;
        const int per = nMg * nNg, g = (int)L / per, r = (int)L % per;
        u.pm = g * nMg + r / nNg; u.pn = g * nNg + r % nNg; return true;
    }
    __device__ __forceinline__ void a_ready(const Unit&) const {}
    __device__ __forceinline__ void done(const Unit&) const {}
};

template <class Epi, class Sched, bool ALIGN_EPI = false, bool SP2 = false>
__device__ __forceinline__ void gemm_phase(PG8_LAS unsigned char* lds, const Gemm g, const Sched& S, const Epi& E) {
    int tid_ = threadIdx.x; asm volatile("" : "+v"(tid_));
    const int tid = tid_, wid = __builtin_amdgcn_readfirstlane(tid >> 6), lane = tid & 63, wr = wid >> 2, wc = wid & 3, fr = lane & 15, fq = lane >> 4;
    const int K = g.K, nt = K / BK;
    unsigned voffA[2], voffB[2];
#pragma unroll
    for (int i = 0; i < 2; ++i) { int R, C; stage_rc(tid * 16 + i * 8192, R, C); const int Rb = Epi::PERM ? ((R & ~31) + perm32(R & 31)) : R;
        voffA[i] = (unsigned)(R * g.ars + (C >> 4) * g.aks + (C & 15)) * 2u; voffB[i] = (unsigned)(Rb * g.ldb + C) * 2u; }
    const size_t kstepA = (size_t)g.aks * 8, kstepB = (size_t)(BK * 2);
    const size_t hstepA = (size_t)HALF * g.ars * 2, hstepB = (size_t)HALF * g.ldb * 2;
    const size_t tstepA = 2 * hstepA, tstepB = 2 * hstepB;
    const unsigned ldsw = (unsigned)wid * 1024u;
    const int aoff = lds_byte(wr * 64 + fr, fq * 8), boff = lds_byte(wc * 32 + fr, fq * 8);
#define PG8_SA(b, h) (((b) * 2 + (h)) * HTB)
#define PG8_SB(b, h) ((4 + (b) * 2 + (h)) * HTB)
#define PG8_STAGE(bufoff, gbase, voff) do { _Pragma("unroll") for (int _i = 0; _i < 2; ++_i) \
        __builtin_amdgcn_global_load_lds((const unsigned*)((const char*)(gbase) + (voff)[_i]), (PG8_LAS unsigned*)(lds + (bufoff) + ldsw + _i * 8192), 16, 0, 0); } while (0)
#define PG8_LDA(dst, b, h) do { _Pragma("unroll") for (int m = 0; m < 4; ++m) _Pragma("unroll") for (int k = 0; k < 2; ++k) dst[m][k] = *(const PG8_LAS bf16x8*)(lds + PG8_SA(b, h) + aoff + m * 2048 + k * 1024); } while (0)
#define PG8_LDB(dst, b, h) do { _Pragma("unroll") for (int n = 0; n < 2; ++n) _Pragma("unroll") for (int k = 0; k < 2; ++k) dst[n][k] = *(const PG8_LAS bf16x8*)(lds + PG8_SB(b, h) + boff + n * 2048 + k * 1024); } while (0)
#define PG8_MMA(ai, bj, At, Bt) do { __builtin_amdgcn_s_setprio(1); _Pragma("unroll") for (int m = 0; m < 4; ++m) _Pragma("unroll") for (int n = 0; n < 2; ++n) _Pragma("unroll") for (int k = 0; k < 2; ++k) \
        acc[ai][bj][m][n] = __builtin_amdgcn_mfma_f32_16x16x32_bf16(Bt[n][k], At[m][k], acc[ai][bj][m][n], 0, 0, 0); __builtin_amdgcn_s_setprio(0); } while (0)
#define PG8_WAIT_V(n) asm volatile("s_waitcnt vmcnt(" #n ")" ::: "memory")
#define PG8_WAIT_L(n) asm volatile("s_waitcnt lgkmcnt(" #n ")" ::: "memory")
#define PG8_BAR __builtin_amdgcn_s_barrier()
#define PG8_SCHED __builtin_amdgcn_sched_barrier(0)
    Unit cur, nxt, prv; int ui = 0;
    if (!S.next(0, cur)) return;
    prv = cur;
    bf16x8 At[4][2], B0[2][2], B1[2][2];
    const char* cA = (const char*)g.A + (size_t)cur.pm * tstepA; const char* cB = (const char*)g.Bt + (size_t)cur.pn * tstepB;
    S.a_ready(cur);
    if constexpr (SP2) {
        PG8_STAGE(PG8_SB(0, 0), cB, voffB); PG8_STAGE(PG8_SB(0, 1), cB + hstepB, voffB); PG8_STAGE(PG8_SA(0, 0), cA, voffA); PG8_STAGE(PG8_SA(0, 1), cA + hstepA, voffA);
        if (wr == 1) PG8_BAR;
        PG8_WAIT_V(2); PG8_BAR;
        PG8_STAGE(PG8_SB(1, 0), cB + kstepB, voffB); PG8_STAGE(PG8_SA(1, 0), cA + kstepA, voffA); PG8_STAGE(PG8_SB(1, 1), cB + hstepB + kstepB, voffB);
        PG8_WAIT_V(6); PG8_BAR;
    } else {
        PG8_STAGE(PG8_SB(0, 0), cB, voffB); PG8_STAGE(PG8_SA(0, 0), cA, voffA); PG8_STAGE(PG8_SB(0, 1), cB + hstepB, voffB); PG8_STAGE(PG8_SA(0, 1), cA + hstepA, voffA);
        if (wr == 1) PG8_BAR;
        PG8_WAIT_V(4); PG8_BAR;
        PG8_STAGE(PG8_SB(1, 0), cB + kstepB, voffB); PG8_STAGE(PG8_SA(1, 0), cA + kstepA, voffA); PG8_STAGE(PG8_SB(1, 1), cB + hstepB + kstepB, voffB);
        PG8_WAIT_V(6); PG8_BAR;
    }
    for (;;) {
        const bool has_next = S.next(ui + 1, nxt);
        f32x4 acc[2][2][4][2];
#pragma unroll
        for (int a = 0; a < 2; ++a)
#pragma unroll
            for (int b = 0; b < 2; ++b)
#pragma unroll
                for (int m = 0; m < 4; ++m)
#pragma unroll
                    for (int n = 0; n < 2; ++n) acc[a][b][m][n] = (f32x4){0.f, 0.f, 0.f, 0.f};
        const char* nA = has_next ? (const char*)g.A + (size_t)nxt.pm * tstepA : cA; const char* nB = has_next ? (const char*)g.Bt + (size_t)nxt.pn * tstepB : cB;
#pragma unroll 1
        for (int kh = 0; kh < 2; ++kh) {
        for (int t = kh * (nt >> 1); t < (kh + 1) * (nt >> 1); t += 2) {
            const bool last = (t == nt - 2);
            const char* a1 = cA + (size_t)(t + 1) * kstepA;
            const char* a2 = last ? nA : cA + (size_t)(t + 2) * kstepA; const char* b2 = last ? nB : cB + (size_t)(t + 2) * kstepB;
            const char* a3 = a2 + kstepA; const char* b3 = b2 + kstepB;
            if (last && has_next) S.a_ready(nxt);
            if constexpr (has_gtab<Epi>::v) { if (last) E.gain_table(cur); }
            if constexpr (SP2) {
            PG8_LDB(B0, 0, 0); PG8_LDB(B1, 0, 1); PG8_SCHED; PG8_LDA(At, 0, 0); PG8_STAGE(PG8_SA(1, 1), a1 + hstepA, voffA);
            PG8_WAIT_V(8); PG8_WAIT_L(0); PG8_BAR; PG8_MMA(0, 0, At, B0); PG8_MMA(0, 1, At, B1); PG8_BAR; PG8_SCHED;
            PG8_LDA(At, 0, 1); PG8_STAGE(PG8_SB(0, 0), b2, voffB); PG8_STAGE(PG8_SB(0, 1), b2 + hstepB, voffB); PG8_STAGE(PG8_SA(0, 0), a2, voffA);
            PG8_WAIT_V(8); PG8_WAIT_L(0); PG8_BAR; PG8_MMA(1, 0, At, B0); PG8_MMA(1, 1, At, B1); PG8_BAR; PG8_SCHED;
            PG8_LDB(B0, 1, 0); PG8_LDB(B1, 1, 1); PG8_SCHED; PG8_LDA(At, 1, 0); PG8_STAGE(PG8_SA(0, 1), a2 + hstepA, voffA);
            PG8_WAIT_V(8); PG8_WAIT_L(0); PG8_BAR; PG8_MMA(0, 0, At, B0); PG8_MMA(0, 1, At, B1); PG8_BAR; PG8_SCHED;
            PG8_LDA(At, 1, 1); PG8_STAGE(PG8_SB(1, 0), b3, voffB); PG8_STAGE(PG8_SB(1, 1), b3 + hstepB, voffB); PG8_STAGE(PG8_SA(1, 0), a3, voffA);
            PG8_WAIT_V(8); PG8_WAIT_L(0); PG8_BAR; PG8_MMA(1, 0, At, B0); PG8_MMA(1, 1, At, B1); PG8_BAR; PG8_SCHED;
            } else {
            PG8_LDB(B0, 0, 0); PG8_SCHED; PG8_LDA(At, 0, 0); PG8_STAGE(PG8_SA(1, 1), a1 + hstepA, voffA);
            PG8_WAIT_L(8); PG8_BAR; PG8_WAIT_L(0); PG8_MMA(0, 0, At, B0); PG8_BAR; PG8_SCHED;
            PG8_LDB(B1, 0, 1); PG8_STAGE(PG8_SB(0, 0), b2, voffB);
            PG8_BAR; PG8_WAIT_L(0); PG8_MMA(0, 1, At, B1); PG8_BAR;
            PG8_LDA(At, 0, 1); PG8_STAGE(PG8_SA(0, 0), a2, voffA);
            PG8_BAR; PG8_WAIT_L(0); PG8_MMA(1, 0, At, B0); PG8_BAR; PG8_SCHED;
            PG8_STAGE(PG8_SB(0, 1), b2 + hstepB, voffB);
            PG8_WAIT_V(6); PG8_BAR; PG8_MMA(1, 1, At, B1); PG8_BAR;
            PG8_LDB(B0, 1, 0); PG8_SCHED; PG8_LDA(At, 1, 0); PG8_STAGE(PG8_SA(0, 1), a2 + hstepA, voffA);
            PG8_WAIT_L(8); PG8_BAR; PG8_WAIT_L(0); PG8_MMA(0, 0, At, B0); PG8_BAR; PG8_SCHED;
            PG8_LDB(B1, 1, 1); PG8_STAGE(PG8_SB(1, 0), b3, voffB);
            PG8_BAR; PG8_WAIT_L(0); PG8_MMA(0, 1, At, B1); PG8_BAR;
            PG8_LDA(At, 1, 1); PG8_STAGE(PG8_SA(1, 0), a3, voffA);
            PG8_BAR; PG8_WAIT_L(0); PG8_MMA(1, 0, At, B0); PG8_BAR; PG8_SCHED;
            PG8_STAGE(PG8_SB(1, 1), b3 + hstepB, voffB);
            PG8_WAIT_V(6); PG8_BAR; PG8_MMA(1, 1, At, B1); PG8_BAR;
            }
        }
        if constexpr (Epi::MIDK) { if (kh == 0) E.midk(acc, cur, wr, wc, fr, fq); }
        }
        if constexpr (ALIGN_EPI) { if (wr == 0) PG8_BAR; }
        if constexpr (has_cnt<Epi>::v) { if (ui > 0) E.count_in(prv); prv = cur; }
        if constexpr (!Epi::AFTER_DRAIN) { E(acc, cur, wr, wc, fr, fq); S.done(cur); }
        if (!has_next) break;
        cur = nxt; cA = nA; cB = nB; ++ui;
        if constexpr (ALIGN_EPI) { if (wr == 1) PG8_BAR; }
    }
    PG8_WAIT_V(0);
    if constexpr (!ALIGN_EPI) { if (wr == 0) PG8_BAR; }
    PG8_BAR;
    if constexpr (has_cnt<Epi>::v) E.count_in(cur);
    static_assert(!Epi::AFTER_DRAIN, "after-drain epilogues are not supported by this body");
#undef PG8_SA
#undef PG8_SB
#undef PG8_STAGE
#undef PG8_LDA
#undef PG8_LDB
#undef PG8_MMA
#undef PG8_WAIT_V
#undef PG8_WAIT_L
#undef PG8_BAR
#undef PG8_SCHED
}
}
constexpr int NWAVES = 8;
constexpr int BATCH = 4, SEQ = 8192, DM = 2048, DEPTH = 4;
constexpr int M = BATCH * SEQ;
constexpr int AW = 1024, NH = 16, HD = 64;
constexpr int SW = 1024, SG = 16, SP = 64, NG = 64;
constexpr int INW = 4096, FF = 8192, NMOD = 6 * DM;
constexpr float LN_EPS = 1e-5f;
constexpr float ALPHA = 1.681792830507429f;

constexpr size_t MiB = 1u << 20;
constexpr size_t WS_CTL = 0, CTL_ZERO_BYTES = 1 * MiB;
constexpr size_t WS_RF = 512 * 1024;
constexpr size_t WS_MODS = 1 * MiB;
constexpr size_t WS_STATS = 1 * MiB + 768 * 1024;
constexpr size_t WS_WIN = 2 * MiB;
constexpr size_t WS_WGLU = WS_WIN + 64 * MiB;
constexpr size_t WS_WOUT = WS_WGLU + 8 * MiB;
constexpr size_t WS_W1 = WS_WOUT + 32 * MiB;
constexpr size_t WS_W2 = WS_W1 + 128 * MiB;
constexpr size_t WS_H = WS_W2 + 128 * MiB;
constexpr size_t WS_YB = WS_H + 128 * MiB;
constexpr size_t WS_MRG = WS_YB + 128 * MiB;
constexpr size_t WS_BIG = WS_MRG + 128 * MiB;
constexpr size_t WS_QKV = WS_BIG, WS_UX = WS_BIG + 192 * MiB, WS_S = WS_BIG + 288 * MiB, WS_YACT = WS_BIG + 352 * MiB  , WS_HID = WS_BIG;
constexpr size_t WS_BST = WS_BIG + 512 * MiB;
constexpr size_t WS_WY = WS_BST + 64 * MiB;
constexpr size_t WS_SSQP = WS_WY + 192 * MiB;
constexpr size_t WS_END = WS_SSQP + 4 * MiB;
constexpr size_t WS_LNCNT = 768 * 1024, WS_LNQ = 768 * 1024 + 8192;
constexpr int CW_BAR = 4096;

constexpr int RING_OFF = 0, RING_BYTES = 131072;
constexpr int LDS_BYTES = 163840;
constexpr int LDSCTL_OFF = LDS_BYTES - 1024, MISC_OFF = LDSCTL_OFF + 320;

#define LAS __attribute__((address_space(3)))
typedef unsigned short bf16;
typedef unsigned v4u __attribute__((ext_vector_type(4)));
typedef float f32x4 __attribute__((ext_vector_type(4)));
typedef short bf16x8 __attribute__((ext_vector_type(8)));
typedef GAS unsigned gu32;
typedef GAS unsigned long long gu64;
#define RLX_AGENT __ATOMIC_RELAXED, __HIP_MEMORY_SCOPE_AGENT
#define LDS_WAIT() asm volatile("s_waitcnt lgkmcnt(0)" ::: "memory")
__device__ __forceinline__ unsigned f2bf(float f) { unsigned u = __builtin_bit_cast(unsigned, f); return (u + 0x7fffu + ((u >> 16) & 1u)) >> 16; }
__device__ __forceinline__ unsigned pk2(float lo, float hi) { return f2bf(lo) | (f2bf(hi) << 16); }

#define XB_TMO      128
#define XB_XCNT(j)  (256  + 64 * (j))
#define XB_XSUB(j)  (1280 + 64 * (j))
#define XB_XGEN(j)  (2304 + 64 * (j))
#define XB_TOP      3328
#define XB_TOPGEN   3392
#define XCD_BAR_WORDS 3456
#define XB_SPIN_CAP (1u << 18)

__device__ __forceinline__ unsigned xb_ld(unsigned* p)              { return __hip_atomic_load(p, __ATOMIC_RELAXED, __HIP_MEMORY_SCOPE_AGENT); }
__device__ __forceinline__ unsigned xb_add(unsigned* p, unsigned v) { return __hip_atomic_fetch_add(p, v, __ATOMIC_RELAXED, __HIP_MEMORY_SCOPE_AGENT); }
__device__ __forceinline__ unsigned xb_xcc_id() { return (unsigned)__builtin_amdgcn_s_getreg((3 << 11) | 20) & 0xFu; }
#define XB_SPIN(cond, bar) do { unsigned _sp = 0; while (cond) { __builtin_amdgcn_s_sleep(1); \
    if ((++_sp & 255u) == 0u) { if (xb_ld(&(bar)[XB_TMO])) break; if (_sp > XB_SPIN_CAP) { atomicAdd(&(bar)[XB_TMO], 1u); break; } } } } while (0)

struct XcdBarrier {
    unsigned* bar; unsigned x;
    volatile LAS unsigned* st;
};

__device__ __forceinline__ XcdBarrier xcd_barrier_post(unsigned* bar, volatile LAS unsigned* st) {
    XcdBarrier b; b.bar = bar; b.x = xb_xcc_id(); b.st = st;
    if (threadIdx.x == 0) (void)xb_add(&bar[XB_XCNT(b.x)], 1u);
    return b;
}
__device__ __forceinline__ void xcd_barrier_complete(unsigned* bar, unsigned x, unsigned& nloc, unsigned& nx) {
    const unsigned G = gridDim.x * gridDim.y * gridDim.z;
    unsigned sum, cnt, mine, sp = 0u;
    for (;;) {
        sum = 0u; cnt = 0u; mine = 0u;
#pragma unroll
        for (unsigned j = 0; j < 16; ++j) { const unsigned c = xb_ld(&bar[XB_XCNT(j)]); sum += c; cnt += (c > 0u) ? 1u : 0u; mine = (j == x) ? c : mine; }
        if (sum == G) break;
        __builtin_amdgcn_s_sleep(1);
        if ((++sp & 255u) == 0u) { if (xb_ld(&bar[XB_TMO])) break; if (sp > XB_SPIN_CAP) { atomicAdd(&bar[XB_TMO], 1u); break; } }
    }
    nloc = mine > 0u ? mine : 1u; nx = cnt > 0u ? cnt : 1u;
}

__device__ __forceinline__ void xcd_barrier(const XcdBarrier& b) {
    asm volatile("s_waitcnt vmcnt(0)" ::: "memory");
    __syncthreads();
    if (threadIdx.x == 0) {
        unsigned* bar = b.bar;
        __builtin_amdgcn_s_waitcnt(0);
        unsigned nloc = b.st[0], nx = b.st[1];
        if (nloc == 0u) { xcd_barrier_complete(bar, b.x, nloc, nx); b.st[0] = nloc; b.st[1] = nx; }
        const unsigned old = xb_add(&bar[XB_XSUB(b.x)], 1u);
        const unsigned gen = old / nloc;
        if (old + 1u == (gen + 1u) * nloc) {
            __builtin_amdgcn_fence(__ATOMIC_RELEASE, "agent");
            asm volatile("s_waitcnt vmcnt(0)" ::: "memory");
            const unsigned og = xb_add(&bar[XB_TOP], 1u);
            const unsigned tg = og / nx;
            if (og + 1u == (tg + 1u) * nx) xb_add(&bar[XB_TOPGEN], 1u);
            else XB_SPIN(xb_ld(&bar[XB_TOPGEN]) == tg, bar);
            __builtin_amdgcn_fence(__ATOMIC_ACQUIRE, "agent");
            xb_add(&bar[XB_XGEN(b.x)], 1u);
            asm volatile("s_waitcnt vmcnt(0)" ::: "memory");
        } else {
            XB_SPIN(xb_ld(&bar[XB_XGEN(b.x)]) == gen, bar);
            __builtin_amdgcn_fence(__ATOMIC_ACQUIRE, "agent");
            asm volatile("s_waitcnt vmcnt(0)" ::: "memory");
        }
    }
    __syncthreads();
}
__device__ __forceinline__ int opaque_tid() { int t = threadIdx.x; asm volatile("" : "+v"(t)); return t; }
__device__ __forceinline__ float wave_sum(float v) {
#pragma unroll
    for (int o = 1; o < 64; o <<= 1) v += __shfl_xor(v, o);
    return v;
}
template <int CTRL> __device__ __forceinline__ float dpp_mov_(float v) { return __uint_as_float((unsigned)__builtin_amdgcn_update_dpp(0, (int)__float_as_uint(v), CTRL, 0xF, 0xF, true)); }
__device__ __forceinline__ float wave_sum_fast(float v) {
    v += dpp_mov_<0xB1>(v); v += dpp_mov_<0x4E>(v); v += dpp_mov_<0x141>(v); v += dpp_mov_<0x140>(v);
    { auto r = __builtin_amdgcn_permlane16_swap(__float_as_uint(v), __float_as_uint(v), false, false); v = __uint_as_float(r[0]) + __uint_as_float(r[1]); }
    { auto r = __builtin_amdgcn_permlane32_swap(__float_as_uint(v), __float_as_uint(v), false, false); v = __uint_as_float(r[0]) + __uint_as_float(r[1]); }
    return v;
}
__device__ __forceinline__ void p0_transpose_item(const float* W, int K, int N, bf16* WT, LAS float* scr, int item, int lane, const float* ga = nullptr, const float* gs = nullptr) {
    const int nblk = N / 32, kb = item / nblk, nb = item % nblk, k0 = 64 * kb, n0 = 32 * nb;
    float wv[32];
#pragma unroll
    for (int i = 0; i < 32; ++i) wv[i] = W[(size_t)(k0 + 2 * i + (lane >> 5)) * N + n0 + (lane & 31)];
#pragma unroll
    for (int i = 0; i < 32; ++i) { const int k = k0 + 2 * i + (lane >> 5); const float gk = ga ? (k < 1024 ? ga[k] : gs[k - 1024]) : 1.f; scr[(2 * i + (lane >> 5)) * 33 + (lane & 31)] = wv[i] * gk; }
    LDS_WAIT(); asm volatile("" ::: "memory");
    const int c = lane & 7;
#pragma unroll
    for (int j = 0; j < 4; ++j) { const int n = (lane >> 3) + 8 * j; const LAS float* s = scr + (8 * c) * 33 + n;
        v4u o; o.x = pk2(s[0 * 33], s[1 * 33]); o.y = pk2(s[2 * 33], s[3 * 33]); o.z = pk2(s[4 * 33], s[5 * 33]); o.w = pk2(s[6 * 33], s[7 * 33]);
        *(GAS v4u*)(WT + (size_t)(n0 + n) * K + k0 + 8 * c) = o; }
    LDS_WAIT(); asm volatile("" ::: "memory");
}
struct Ptrs {
    const float* in[24]; float* out; unsigned char* ws;
};

__device__ __forceinline__ void p0_weights(LAS unsigned char* lds, int gw, int ngw, int wave) {
    const int lane = opaque_tid() & 63;
    LAS float* scr = (LAS float*)(lds + RING_OFF + wave * 16384);
    constexpr int I_IN = (DM / 64) * (INW / 32), I_GLU = (SW / 64) * (SW / 32), I_OUT = (DM / 64) * (DM / 32), I_1 = (DM / 64) * (FF / 32), I_2 = (FF / 64) * (DM / 32);
    constexpr int PER_LAYER = I_IN + I_GLU + I_OUT + I_1 + I_2;
    for (int it = gw; it < DEPTH * PER_LAYER; it += ngw) {
        const int l = it / PER_LAYER; int r = it % PER_LAYER;
        if (r < I_IN) { p0_transpose_item(IN(4) + (size_t)l * DM * INW, DM, INW, (bf16*)(WSP() + WS_WIN) + (size_t)l * INW * DM, scr, r, lane); continue; } r -= I_IN;
        if (r < I_GLU) { p0_transpose_item(IN(13) + (size_t)l * SW * SW, SW, SW, (bf16*)(WSP() + WS_WGLU) + (size_t)l * SW * SW, scr, r, lane); continue; } r -= I_GLU;
        if (r < I_OUT) { p0_transpose_item(IN(17) + (size_t)l * DM * DM, DM, DM, (bf16*)(WSP() + WS_WOUT) + (size_t)l * DM * DM, scr, r, lane, IN(15) + (size_t)l * AW, IN(16) + (size_t)l * SW); continue; } r -= I_OUT;
        if (r < I_1) { p0_transpose_item(IN(20) + (size_t)l * DM * FF, DM, FF, (bf16*)(WSP() + WS_W1) + (size_t)l * FF * DM, scr, r, lane); continue; } r -= I_1;
        p0_transpose_item(IN(21) + (size_t)l * FF * DM, FF, DM, (bf16*)(WSP() + WS_W2) + (size_t)l * DM * FF, scr, r, lane);
    }
}
__device__ __forceinline__ void p0_mods(LAS unsigned char* lds, int wave) {
    const int tid = opaque_tid(), lane = tid & 63;
    LAS float* cond = (LAS float*)(lds);
    LAS float* part = (LAS float*)(lds + 32768);
    const float* c = IN(1);
    for (int i = tid; i < BATCH * DM; i += NWAVES * 64) { const float v = c[i]; cond[i] = v / (1.f + __expf(-v)); }
    __syncthreads();
    float* mods = (float*)(WSP() + WS_MODS);
    constexpr int NCH = NMOD / 128;
    for (int it = blockIdx.x; it < DEPTH * NCH; it += gridDim.x) {
        const int l = it / NCH, n0 = (it % NCH) * 128;
        const float* W = IN(2) + (size_t)l * DM * NMOD + n0 + 4 * (lane & 31);
        const int kbase = wave * 256 + (lane >> 5);
        f32x4 a0 = {0.f, 0.f, 0.f, 0.f}, a1 = a0, a2 = a0, a3 = a0;
#pragma unroll 8
        for (int i = 0; i < 128; ++i) { const int k = kbase + 2 * i; const f32x4 w = *(const f32x4*)(W + (size_t)k * NMOD);
            a0 += w * cond[k]; a1 += w * cond[DM + k]; a2 += w * cond[2 * DM + k]; a3 += w * cond[3 * DM + k]; }
        const int slot = wave * 2 + (lane >> 5), cc = 4 * (lane & 31);
        *(LAS f32x4*)(part + (slot * 4 + 0) * 128 + cc) = a0; *(LAS f32x4*)(part + (slot * 4 + 1) * 128 + cc) = a1;
        *(LAS f32x4*)(part + (slot * 4 + 2) * 128 + cc) = a2; *(LAS f32x4*)(part + (slot * 4 + 3) * 128 + cc) = a3;
        __syncthreads();
        { const int b = tid >> 7, col = tid & 127; float s = 0.f;
#pragma unroll
          for (int sl = 0; sl < 16; ++sl) s += part[(sl * 4 + b) * 128 + col];
          mods[((size_t)l * BATCH + b) * NMOD + n0 + col] = s + IN(3)[(size_t)l * NMOD + n0 + col]; }
        __syncthreads();
    }
}
__device__ __forceinline__ void row_mod_pass(const float* X, bf16* H, bf16* YB, const float* mods_l  , int sh_off, int sc_off, int gw, int ngw) {
    const int lane = opaque_tid() & 63;
    for (int r = gw; r < M; r += ngw) {
        const int b = r / SEQ; const float* mb = mods_l + (size_t)b * NMOD;
        const float* xr = X + (size_t)r * DM; bf16* hr = H + (size_t)r * DM; bf16* yr = YB + (size_t)r * DM;
#pragma unroll
        for (int j = 0; j < 8; ++j) { const int col = 4 * (64 * j + lane);
            const f32x4 v = *(const f32x4*)(xr + col), sc = *(const f32x4*)(mb + sc_off + col), sh = *(const f32x4*)(mb + sh_off + col);
            const f32x4 h = v * (sc + 1.0f) + sh;
            uint2 o; o.x = pk2(h[0], h[1]); o.y = pk2(h[2], h[3]); *(uint2*)(hr + col) = o;
            { typedef _Float16 f16x4 __attribute__((ext_vector_type(4))); const f16x4 y = {(_Float16)v[0], (_Float16)v[1], (_Float16)v[2], (_Float16)v[3]}; *(uint2*)(yr + col) = __builtin_bit_cast(uint2, y); } }
    }
}
__device__ __forceinline__ void ln_row_math(int r, int lane, const v4u (&w)[4], bf16* H, float* XO, float* stats, const float* lg, const float* lb, const float* mods_l, int sh_off, int sc_off) {
    float v[4][8]; float s = 0.f;
#pragma unroll
    for (int j = 0; j < 4; ++j) {
        { f32x4 a_, b_; pg8::unpack_f16x8(w[j], a_, b_); v[j][0] = a_[0]; v[j][1] = a_[1]; v[j][2] = a_[2]; v[j][3] = a_[3]; v[j][4] = b_[0]; v[j][5] = b_[1]; v[j][6] = b_[2]; v[j][7] = b_[3]; }
#pragma unroll
        for (int e = 0; e < 8; ++e) s += v[j][e]; }
    const float mean = wave_sum_fast(s) * (1.f / DM); float s2 = 0.f;
#pragma unroll
    for (int j = 0; j < 4; ++j)
#pragma unroll
        for (int e = 0; e < 8; ++e) { v[j][e] -= mean; s2 += v[j][e] * v[j][e]; }
    const float rstd = 1.f / sqrtf(wave_sum_fast(s2) * (1.f / DM) + LN_EPS);
    if (lane == 0) { *(float2*)(stats + 2 * (size_t)r) = make_float2(mean, rstd); }
    const int b = r / SEQ; const float* mb = mods_l ? mods_l + (size_t)b * NMOD : nullptr; bf16* hr = H + (size_t)r * DM;
#pragma unroll
    for (int j = 0; j < 4; ++j) { const int col = 8 * (64 * j + lane);
        f32x4 x[2];
#pragma unroll
        for (int q = 0; q < 2; ++q) { const f32x4 vv = {v[j][4 * q], v[j][4 * q + 1], v[j][4 * q + 2], v[j][4 * q + 3]}; x[q] = vv * rstd * *(const f32x4*)(lg + col + 4 * q) + *(const f32x4*)(lb + col + 4 * q); }
        if (XO) { *(f32x4*)(XO + (size_t)r * DM + col) = x[0]; *(f32x4*)(XO + (size_t)r * DM + col + 4) = x[1]; }
        if (mb) { f32x4 h[2];
#pragma unroll
            for (int q = 0; q < 2; ++q) h[q] = x[q] * (*(const f32x4*)(mb + sc_off + col + 4 * q) + 1.0f) + *(const f32x4*)(mb + sh_off + col + 4 * q);
            v4u o; o.x = pk2(h[0][0], h[0][1]); o.y = pk2(h[0][2], h[0][3]); o.z = pk2(h[1][0], h[1][1]); o.w = pk2(h[1][2], h[1][3]); *(v4u*)(hr + col) = o; } }
}
__device__ __forceinline__ void ln_rows4_sc1(const bf16* YB, bf16* H, float* XO, float* stats, const float* lg, const float* lb, const float* mods_l, int sh_off, int sc_off, int r0) {
    const int lane = opaque_tid() & 63;
    v4u w[4][4];
#pragma unroll
    for (int k = 0; k < 4; ++k)
#pragma unroll
        for (int j = 0; j < 4; ++j) { const bf16* p = YB + (size_t)(r0 + k) * DM + 8 * (64 * j + lane); asm volatile("global_load_dwordx4 %0, %1, off sc1" : "=&v"(w[k][j]) : "v"(p) : "memory"); }
    asm volatile("s_waitcnt vmcnt(0)" : "+v"(w[0][0]), "+v"(w[0][1]), "+v"(w[0][2]), "+v"(w[0][3]), "+v"(w[1][0]), "+v"(w[1][1]), "+v"(w[1][2]), "+v"(w[1][3]),
                                         "+v"(w[2][0]), "+v"(w[2][1]), "+v"(w[2][2]), "+v"(w[2][3]), "+v"(w[3][0]), "+v"(w[3][1]), "+v"(w[3][2]), "+v"(w[3][3]) :: "memory");
#pragma unroll
    for (int k = 0; k < 4; ++k) ln_row_math(r0 + k, lane, w[k], H, XO, stats, lg, lb, mods_l, sh_off, sc_off);
}
__device__ __forceinline__ void ln_queue_pass(LAS unsigned char* lds, int inst, const bf16* YB, bf16* H, float* XO, float* stats, const float* lg, const float* lb, const float* mods_l, int sh_off, int sc_off, int G) {
    typedef GAS unsigned gu32_;
    gu32_* q = (gu32_*)(WSP() + WS_LNQ) + inst * 64; gu32_* cnt = (gu32_*)(WSP() + WS_LNCNT) + inst * 128;
    volatile LAS unsigned* bc = (volatile LAS unsigned*)(lds + LDSCTL_OFF + 1008);
    const int tid = opaque_tid(), wave = tid >> 6;
    for (unsigned it = 0;; ++it) {
        if (tid == 0) { const unsigned hp = __hip_atomic_fetch_add(q, 1u, __ATOMIC_RELAXED, __HIP_MEMORY_SCOPE_AGENT);
            if (hp < 1024u) { const unsigned n = hp >> 3; unsigned panel = n;
                if (G == 256) { const unsigned i = n >> 5, rem = n & 31u; panel = 4u * ((rem >> 2) * 4u + i) + (rem & 3u); }
                for (unsigned spins = 0; __hip_atomic_load(cnt + panel, __ATOMIC_RELAXED, __HIP_MEMORY_SCOPE_AGENT) != 8u && spins < (1u << 24); ++spins) __builtin_amdgcn_s_sleep(4);
                bc[it & 1u] = panel * 256u + (hp & 7u) * 32u; }
            else bc[it & 1u] = 0xFFFFFFFFu; }
        __syncthreads();
        const unsigned rb = bc[it & 1u];
        if (rb == 0xFFFFFFFFu) break;
        ln_rows4_sc1(YB, H, XO, stats, lg, lb, mods_l, sh_off, sc_off, (int)rb + wave * 4);
    }
}
__device__ __forceinline__ void row_factor_pass(const float* SSQP  , float* RF  , int gtid0, int ngt) {
    const int gtid = gtid0 + opaque_tid();
    for (int r = gtid; r < M; r += ngt) {
        float sa = 0.f, ss = 0.f;
#pragma unroll
        for (int j = 0; j < 4; ++j) { const f32x4 a = *(const f32x4*)(SSQP + (size_t)r * 16 + 4 * j), s = *(const f32x4*)(SSQP + ((size_t)M + r) * 16 + 4 * j);
            sa += (a[0] + a[1]) + (a[2] + a[3]); ss += (s[0] + s[1]) + (s[2] + s[3]); }
        const float va = sa * (1.f / AW) + LN_EPS, vs = ss * (1.f / SW) + LN_EPS;
        *(float2*)(RF + 2 * (size_t)r) = make_float2(sqrtf(vs / va), 1.0f / sqrtf(vs));
    }
}
namespace at3 {
typedef short bf16x8 __attribute__((ext_vector_type(8)));
typedef short s16x4 __attribute__((ext_vector_type(4)));
typedef short v4i16_t __attribute__((ext_vector_type(4)));
typedef float f32x4 __attribute__((ext_vector_type(4)));
typedef float f32x2_t __attribute__((ext_vector_type(2))); typedef __bf16 bf16x2_t __attribute__((ext_vector_type(2)));
__device__ __forceinline__ unsigned cvtpk(float lo, float hi) { f32x2_t v = {lo, hi}; bf16x2_t b = __builtin_convertvector(v, bf16x2_t); return __builtin_bit_cast(unsigned, b); }
#define AT_LAS __attribute__((address_space(3)))
#define WG_BAR() asm volatile("s_waitcnt lgkmcnt(0)\n\ts_barrier" ::: "memory")
constexpr int NSTG = 27, NS1 = 5, NS2 = 11, NSLOT2 = 21;
constexpr int KROW = 144, KIMG = 32 * KROW, SUBI = 1056, VIMG = 4 * SUBI, WIMG = KIMG + VIMG;
constexpr int OLW = 68;
constexpr int LDS_OL = 8 * WIMG, LDS_ML = LDS_OL + 256 * OLW * 4, LDS_LL = LDS_ML + 1024, LDS_ATT_END = LDS_LL + 1024;
constexpr float QSCALE = 0.125f * 1.4426950408889634f;
constexpr float THR = 8.f;
__host__ __device__ constexpr int p2_pi(int t) { return t < 9 ? 0 : 1; }
__host__ __device__ constexpr int pi_d(int pi) { return pi == 0 ? 16 : (pi == 1 ? 4 : 1); }
__host__ __device__ constexpr int p2_mt(int t) { return t < 9 ? 16 * t : 16 * (t - 9); }
struct UnitCtx { const char* Kb; const char* Vb; const char* Qb; char* Ob; float* Sq; int T0; };
struct LaneK { unsigned voffR[3]; float jfb0[3]; int lane; };
__device__ __forceinline__ float lane_max16(float x) { auto r = __builtin_amdgcn_permlane16_swap(__float_as_uint(x), __float_as_uint(x), false, false); return fmaxf(__uint_as_float(r[0]), __uint_as_float(r[1])); }
__device__ __forceinline__ float lane_max32(float x) { auto r = __builtin_amdgcn_permlane32_swap(__float_as_uint(x), __float_as_uint(x), false, false); return fmaxf(__uint_as_float(r[0]), __uint_as_float(r[1])); }
template <int S> struct StageInfo {
    static constexpr bool P1 = S < NS1;
    static constexpr int ls = P1 ? S : (S - NS1) % NS2;
    static constexpr int setB = P1 ? 0 : (S - NS1) / NS2;
    static constexpr int slot(int hh) { return 2 * ls + hh; }
};
template <int S> __device__ __forceinline__ void issue_stage(const UnitCtx& c, int wave, const LaneK& L, v4u (&kf)[4], v4u (&vf)[4]) {
    typedef StageInfo<S> SI;
#pragma unroll
    for (int cc = 0; cc < 4; ++cc) {
        long tok; int pi;
        if constexpr (SI::P1) { pi = 2; tok = c.T0 + 32 * wave - 64 + 32 * SI::ls + 8 * cc; }
        else { const int t = (SI::slot(cc >> 1) < NSLOT2) ? SI::slot(cc >> 1) : SI::slot(0); pi = p2_pi(t); const int d = pi_d(pi);
               tok = c.T0 + 2 * wave + SI::setB - 64 * d + d * (p2_mt(t) + 8 * (cc & 1)); }
        const long off = tok * (HD * 2);
        kf[cc] = *(const v4u*)(c.Kb + off + L.voffR[pi]); vf[cc] = *(const v4u*)(c.Vb + off + L.voffR[pi]); }
}
__device__ __forceinline__ void write_images(AT_LAS unsigned char* img, int lane, const v4u (&kf)[4], const v4u (&vf)[4]) {
    AT_LAS unsigned char* kp = img + (lane >> 3) * KROW + (lane & 7) * 16;
    AT_LAS unsigned char* vp = img + KIMG + ((lane & 7) >> 1) * SUBI + (lane >> 3) * 32 + (lane & 1) * 16;
#pragma unroll
    for (int cc = 0; cc < 4; ++cc) { *(AT_LAS v4u*)(kp + cc * 8 * KROW) = kf[cc]; *(AT_LAS v4u*)(vp + cc * 256) = vf[cc]; }
}
__device__ __forceinline__ void read_kfrag(const AT_LAS unsigned char* img, int lane, bf16x8 (&ka)[4]) {
    const AT_LAS unsigned char* p = img + (lane & 15) * KROW + (lane >> 4) * 16;
#pragma unroll
    for (int hh = 0; hh < 2; ++hh) { ka[2 * hh] = *(const AT_LAS bf16x8*)(p + hh * 16 * KROW); ka[2 * hh + 1] = *(const AT_LAS bf16x8*)(p + hh * 16 * KROW + 64); }
}
__device__ __forceinline__ void read_vfrag(const AT_LAS unsigned char* img, int lane, bf16x8 (&va)[4]) {
    const AT_LAS unsigned char* vb = img + KIMG + (4 * (lane >> 4) + ((lane & 15) >> 2)) * 32 + 8 * (lane & 3);
#pragma unroll
    for (int cc = 0; cc < 4; ++cc) {
        const s16x4 lo = __builtin_bit_cast(s16x4, __builtin_amdgcn_ds_read_tr16_b64_v4i16((AT_LAS v4i16_t*)(vb + cc * SUBI)));
        const s16x4 hi = __builtin_bit_cast(s16x4, __builtin_amdgcn_ds_read_tr16_b64_v4i16((AT_LAS v4i16_t*)(vb + cc * SUBI + 512)));
        va[cc] = (bf16x8){lo[0], lo[1], lo[2], lo[3], hi[0], hi[1], hi[2], hi[3]}; }
}
__device__ __forceinline__ bf16x8 softmax_step(const bf16x8 (&ka)[4], const bf16x8 (&qf)[2], const float (&jf0)[2], const float (&jc)[2], const bool (&have)[2], const float (&bsv)[2],
                                               const float (&jlo)[2], const float (&jhi)[2], f32x4 (&oacc)[4], float& m_run, float& l_run) {
    const f32x4 z = {0.f, 0.f, 0.f, 0.f};
    float s[8];
#pragma unroll
    for (int hh = 0; hh < 2; ++hh) {
        if (have[hh]) {
            f32x4 st = __builtin_amdgcn_mfma_f32_16x16x32_bf16(ka[2 * hh], qf[0], z, 0, 0, 0); st = __builtin_amdgcn_mfma_f32_16x16x32_bf16(ka[2 * hh + 1], qf[1], st, 0, 0, 0);
#pragma unroll
            for (int e = 0; e < 4; ++e) { const float jf = jf0[hh] + (jc[hh] + (float)e); const bool valid = (jf >= jlo[hh]) && (jf <= jhi[hh]);
                s[4 * hh + e] = valid ? __builtin_fmaf(-bsv[hh], __builtin_fabsf(jf), st[e]) : -__builtin_inff(); }
        } else {
#pragma unroll
            for (int e = 0; e < 4; ++e) s[4 * hh + e] = -__builtin_inff(); } }
    float mx = fmaxf(fmaxf(fmaxf(s[0], s[1]), fmaxf(s[2], s[3])), fmaxf(fmaxf(s[4], s[5]), fmaxf(s[6], s[7])));
    mx = lane_max16(mx); mx = lane_max32(mx);
    if (__any(mx > m_run + THR)) {
        const float mn = fmaxf(m_run, mx), alpha = __builtin_amdgcn_exp2f(m_run - mn); m_run = mn; l_run *= alpha;
#pragma unroll
        for (int cc = 0; cc < 4; ++cc) oacc[cc] = oacc[cc] * alpha; }
    float p[8]; float ps = 0.f;
#pragma unroll
    for (int k = 0; k < 8; ++k) { p[k] = __builtin_amdgcn_exp2f(s[k] - m_run); ps += p[k]; }
    l_run += ps;
    unsigned pw[4] = {cvtpk(p[0], p[1]), cvtpk(p[2], p[3]), cvtpk(p[4], p[5]), cvtpk(p[6], p[7])};
    return __builtin_bit_cast(bf16x8, *(const v4u*)pw);
}
struct WaveState {
    bf16x8 q1[2][2], q2[2], qn[2];
    f32x4 o1[2][4], o2[4]; float m1[2], l1[2], m2, l2;
    float jlo1[2], jhi1[2], jlo2[2], jhi2[2];
};
__device__ __forceinline__ void load_q(const char* Qb, long tok0, int stride, int lane_, bf16x8 (&qf)[2]) {
    const int lane = opaque_tid() & 63; (void)lane_;
    const char* qp = Qb + ((tok0 + (long)stride * (lane & 15)) * AW + 8 * (lane >> 4)) * 2; qf[0] = *(const bf16x8*)qp; qf[1] = *(const bf16x8*)(qp + 64); }
template <int S> __device__ __forceinline__ void compute_stage(const UnitCtx& c, int wave, const LaneK& L, const float (&bs)[3], AT_LAS unsigned char* lds, AT_LAS unsigned char* img,
                                                               const v4u (&kf)[4], const v4u (&vf)[4], WaveState& W) {
    typedef StageInfo<S> SI;
    const int lane = L.lane, n = lane & 15, g = lane >> 4;
    write_images(img, lane, kf, vf);
    bf16x8 ka[4], va[4];
    read_kfrag(img, lane, ka);
    if constexpr (SI::P1) {
        bf16x8 pb[2];
#pragma unroll
        for (int s2 = 0; s2 < 2; ++s2) {
            const float jf0[2] = {L.jfb0[2], L.jfb0[2]}, jc[2] = {(float)(32 * SI::ls - 16 * s2), (float)(32 * SI::ls + 16 - 16 * s2)}; const bool have[2] = {true, true};
            const float bsv[2] = {bs[2], bs[2]}, jlo[2] = {W.jlo1[s2], W.jlo1[s2]}, jhi[2] = {W.jhi1[s2], W.jhi1[s2]};
            pb[s2] = softmax_step(ka, W.q1[s2], jf0, jc, have, bsv, jlo, jhi, W.o1[s2], W.m1[s2], W.l1[s2]); }
        read_vfrag(img, lane, va);
#pragma unroll
        for (int s2 = 0; s2 < 2; ++s2)
#pragma unroll
            for (int cc = 0; cc < 4; ++cc) W.o1[s2][cc] = __builtin_amdgcn_mfma_f32_16x16x32_bf16(va[cc], pb[s2], W.o1[s2][cc], 0, 0, 0);
    } else {
        constexpr int t0 = SI::slot(0), t1 = SI::slot(1); constexpr bool h1 = t1 < NSLOT2; constexpr int t1c = h1 ? t1 : t0;
        constexpr int p0 = p2_pi(t0), p1 = p2_pi(t1c);
        const float jf0[2] = {L.jfb0[p0], L.jfb0[p1]}, jc[2] = {(float)p2_mt(t0), (float)p2_mt(t1c)}; const bool have[2] = {true, h1};
        const float bsv[2] = {bs[p0], bs[p1]}, jlo[2] = {W.jlo2[p0], W.jlo2[p1]}, jhi[2] = {W.jhi2[p0], W.jhi2[p1]};
        const bf16x8 pb = softmax_step(ka, W.q2, jf0, jc, have, bsv, jlo, jhi, W.o2, W.m2, W.l2);
        read_vfrag(img, lane, va);
#pragma unroll
        for (int cc = 0; cc < 4; ++cc) W.o2[cc] = __builtin_amdgcn_mfma_f32_16x16x32_bf16(va[cc], pb, W.o2[cc], 0, 0, 0);
    }
}
__device__ __forceinline__ void jwin(int tq, int sh, float& lo, float& hi) { const int a = -(tq >> sh), b = (SEQ - 1 - tq) >> sh; lo = (float)(a < -64 ? -64 : a); hi = (float)(b > 64 ? 64 : b); }
__device__ __forceinline__ void begin_pass1(const UnitCtx& c, int wave, const LaneK& L, WaveState& W) {
    const int n = opaque_tid() & 15;
#pragma unroll
    for (int s2 = 0; s2 < 2; ++s2) { W.m1[s2] = -1e30f; W.l1[s2] = 0.f; jwin(c.T0 + 32 * wave + 16 * s2 + n, 0, W.jlo1[s2], W.jhi1[s2]);
#pragma unroll
        for (int cc = 0; cc < 4; ++cc) W.o1[s2][cc] = (f32x4){0.f, 0.f, 0.f, 0.f}; }
}
__device__ __forceinline__ void end_pass1(int wave, const LaneK& L, AT_LAS unsigned char* lds, WaveState& W) {
    const int ln_ = opaque_tid() & 63, n = ln_ & 15, g = ln_ >> 4;
#pragma unroll
    for (int s2 = 0; s2 < 2; ++s2) { const int q = 32 * wave + 16 * s2 + n;
        float lt = W.l1[s2]; lt += __shfl_xor(lt, 16); lt += __shfl_xor(lt, 32);
#pragma unroll
        for (int cc = 0; cc < 4; ++cc) *(AT_LAS f32x4*)(lds + LDS_OL + (q * OLW + 16 * cc + 4 * g) * 4) = W.o1[s2][cc];
        if (g == 0) { *(AT_LAS float*)(lds + LDS_ML + 4 * q) = W.m1[s2]; *(AT_LAS float*)(lds + LDS_LL + 4 * q) = lt; } }
}
__device__ __forceinline__ void begin_pass2(const UnitCtx& c, int r, const LaneK& L, AT_LAS unsigned char* lds, WaveState& W) {
    const int ln_ = opaque_tid() & 63, n = ln_ & 15, g = ln_ >> 4, q = r + 16 * n;
#pragma unroll
    for (int cc = 0; cc < 4; ++cc) W.o2[cc] = *(const AT_LAS f32x4*)(lds + LDS_OL + (q * OLW + 16 * cc + 4 * g) * 4);
    W.m2 = *(const AT_LAS float*)(lds + LDS_ML + 4 * q); const float lq = *(const AT_LAS float*)(lds + LDS_LL + 4 * q); W.l2 = (g == 0) ? lq : 0.f;
    jwin(c.T0 + q, 4, W.jlo2[0], W.jhi2[0]); jwin(c.T0 + q, 2, W.jlo2[1], W.jhi2[1]);
}
__device__ __forceinline__ void end_pass2(const UnitCtx& c, int r, const LaneK& L, WaveState& W) {
    const int ln_ = opaque_tid() & 63, n = ln_ & 15, g = ln_ >> 4;
    float lt = W.l2; lt += __shfl_xor(lt, 16); lt += __shfl_xor(lt, 32);
    const float inv = 1.f / lt;
    char* op = c.Ob + ((long)(c.T0 + r + 16 * n) * DM + 4 * g) * 2;
    float sq = 0.f;
#pragma unroll
    for (int cc = 0; cc < 4; ++cc) { const f32x4 o = W.o2[cc] * inv; sq += (o[0] * o[0] + o[1] * o[1]) + (o[2] * o[2] + o[3] * o[3]);
        uint2 w; w.x = cvtpk(o[0], o[1]); w.y = cvtpk(o[2], o[3]); *(uint2*)(op + 32 * cc) = w; }
    sq += __shfl_xor(sq, 16); sq += __shfl_xor(sq, 32);
    if (g == 0) c.Sq[(size_t)(c.T0 + r + 16 * n) * 16] = sq;
}
template <int S> struct StageLoop {
    static __device__ __forceinline__ void run(const UnitCtx& cur, const UnitCtx& nxt, int wave, const LaneK& L, const float (&bs)[3], AT_LAS unsigned char* lds, AT_LAS unsigned char* img,
                                               v4u (&kf)[3][4], v4u (&vf)[3][4], WaveState& W) {
        constexpr int T = S + 2;
        if constexpr (T < NSTG) issue_stage<T>(cur, wave, L, kf[T % 3], vf[T % 3]);
        else issue_stage<T - NSTG>(nxt, wave, L, kf[T % 3], vf[T % 3]);
        if constexpr (S == NS1 - 3) load_q(cur.Qb, cur.T0 + 2 * wave, 16, L.lane, W.q2);
        if constexpr (S == NS1 + NS2 - 3) load_q(cur.Qb, cur.T0 + 2 * wave + 1, 16, L.lane, W.qn);
        if constexpr (S == NSTG - 3) { load_q(nxt.Qb, nxt.T0 + 32 * wave, 1, L.lane, W.q1[0]); load_q(nxt.Qb, nxt.T0 + 32 * wave + 16, 1, L.lane, W.q1[1]); }
        __builtin_amdgcn_sched_barrier(0);
        if constexpr (S == 0) begin_pass1(cur, wave, L, W);
        if constexpr (S == NS1) { end_pass1(wave, L, lds, W); WG_BAR(); begin_pass2(cur, 2 * wave, L, lds, W); }
        if constexpr (S == NS1 + NS2) { end_pass2(cur, 2 * wave, L, W); W.q2[0] = W.qn[0]; W.q2[1] = W.qn[1]; begin_pass2(cur, 2 * wave + 1, L, lds, W); WG_BAR(); }
        compute_stage<S>(cur, wave, L, bs, lds, img, kf[S % 3], vf[S % 3], W);
        if constexpr (S == NSTG - 1) end_pass2(cur, 2 * wave + 1, L, W);
        __builtin_amdgcn_sched_barrier(0);
        StageLoop<S + 1>::run(cur, nxt, wave, L, bs, lds, img, kf, vf, W);
    }
};
template <> struct StageLoop<NSTG> { static __device__ __forceinline__ void run(const UnitCtx&, const UnitCtx&, int, const LaneK&, const float (&)[3], AT_LAS unsigned char*, AT_LAS unsigned char*, v4u (&)[3][4], v4u (&)[3][4], WaveState&) {} };
__device__ __forceinline__ UnitCtx make_ctx(const bf16* Q, const bf16* K, const bf16* V, bf16* O, float* SSQ, int u) {
    const int sb = u & 31, h = (u >> 5) & 15, b = u >> 9; const size_t rb = (size_t)b * SEQ;
    UnitCtx c; c.Kb = (const char*)(K + ((size_t)h * M + rb) * HD); c.Vb = (const char*)(V + ((size_t)h * M + rb) * HD);
    c.Qb = (const char*)(Q + rb * AW + h * HD); c.Ob = (char*)(O + rb * DM + h * HD); c.Sq = SSQ + rb * 16 + h; c.T0 = sb * 256; return c;
}
__device__ __forceinline__ void attn_phase(const bf16* Q, const bf16* K, const bf16* V, bf16* O  , float* SSQ, AT_LAS unsigned char* lds, int vcu, int G, int wave) {
    LaneK L; L.lane = opaque_tid() & 63;
    const int lane = L.lane, n = lane & 15, g = lane >> 4;
#pragma unroll
    for (int pi = 0; pi < 3; ++pi) { const int d = pi_d(pi); L.voffR[pi] = (unsigned)(d * (lane >> 3) * HD + 8 * (lane & 7)) * 2u; L.jfb0[pi] = (float)(4 * g - 64 - (pi == 2 ? 1 : 16 / d) * n); }
    AT_LAS unsigned char* img = lds + wave * WIMG;
    const int NU = BATCH * NH * (SEQ / 256);
    if (vcu >= NU) return;
    UnitCtx cur = make_ctx(Q, K, V, O, SSQ, vcu);
    v4u kf[3][4], vf[3][4]; WaveState W;
    load_q(cur.Qb, cur.T0 + 32 * wave, 1, lane, W.q1[0]); load_q(cur.Qb, cur.T0 + 32 * wave + 16, 1, lane, W.q1[1]);
    issue_stage<0>(cur, wave, L, kf[0], vf[0]); issue_stage<1>(cur, wave, L, kf[1], vf[1]);
#pragma unroll 1
    for (int k = 0;; ++k) {
        asm volatile("" : "+v"(L.jfb0[0]), "+v"(L.jfb0[1]), "+v"(L.jfb0[2]));
        const int un = vcu + G * (k + 1); const bool has_next = un < NU;
        const UnitCtx nxt = has_next ? make_ctx(Q, K, V, O, SSQ, un) : cur;
        const int h = ((vcu + G * k) >> 5) & 15;
        const float slope2 = exp2f(-0.5f * (float)(h + 1)) * 1.4426950408889634f;
        const float bs[3] = {slope2 * 16.f, slope2 * 4.f, slope2};
        StageLoop<0>::run(cur, nxt, wave, L, bs, lds, img, kf, vf, W);
        if (!has_next) break;
        cur = nxt;
    }
}
}


constexpr int CH = 32, NCHUNK = M / CH  , CPS = SEQ / CH  , KX = 768;
constexpr int T_PW = 0;
constexpr int T_BB = 8192;
constexpr int T_CC = 12288;
constexpr int T_KT = 16384;
typedef float f32x2v __attribute__((ext_vector_type(2)));
__device__ __forceinline__ f32x2v cmul(f32x2v a, f32x2v b) { return (f32x2v){a.x * b.x - a.y * b.y, a.x * b.y + a.y * b.x}; }
__device__ __forceinline__ void ssm_prep_item(int l, int g, LAS unsigned char* lds, bf16* BST  , bf16* WY  ) {
    const int tid = opaque_tid();
    LAS float* T = (LAS float*)lds;
    LAS f32x2v* PW = (LAS f32x2v*)(T + T_PW); LAS f32x2v* BB = (LAS f32x2v*)(T + T_BB); LAS f32x2v* CC = (LAS f32x2v*)(T + T_CC); LAS float* KT = T + T_KT;
    {
#pragma unroll 1
        for (int k = 0; k < 4; ++k) { const int idx = tid + 512 * k; const int dir = idx >> 10, p = (idx >> 4) & 63, c = idx & 15;
            const size_t gi = ((size_t)l * 2 + dir) * NG + g;
            const float step = __expf(IN(7)[gi]); const float lr = IN(5)[gi * SP + p], li = IN(6)[gi * SP + p];
            const float mag = __expf(lr * step); float sn, cs; sincosf(li * step, &sn, &cs);
            const float a_re = mag * cs, a_im = mag * sn, den = lr * lr + li * li;
            const float cf_re = ((a_re - 1.f) * lr + a_im * li) / den, cf_im = (a_im * lr - (a_re - 1.f) * li) / den;
            const float br = IN(8)[(gi * SP + p) * SG + c], bi = IN(9)[(gi * SP + p) * SG + c];
            BB[(dir * 64 + p) * 16 + c] = (f32x2v){cf_re * br - cf_im * bi, cf_re * bi + cf_im * br};
            const int co = (idx >> 6) & 15, pp = idx & 63;
            CC[idx] = (f32x2v){IN(10)[(gi * SG + co) * SP + pp], IN(11)[(gi * SG + co) * SP + pp]}; }
        if (tid < 128) { const int dir = tid >> 6, p = tid & 63; const size_t gi = ((size_t)l * 2 + dir) * NG + g;
            const float step = __expf(IN(7)[gi]); const float lr = IN(5)[gi * SP + p], li = IN(6)[gi * SP + p];
#pragma unroll 1
            for (int e = 1; e <= 32; ++e) { const float mag = __expf(lr * step * (float)e); float sn, cs; sincosf(li * step * (float)e, &sn, &cs);
                PW[(dir * 32 + (e - 1)) * 64 + p] = (f32x2v){mag * cs, mag * sn}; } }
    }
    __syncthreads();
#define PWR_(dir, e, p) ((e) == 0 ? (f32x2v){1.f, 0.f} : PW[((dir) * 32 + ((e) > 0 ? (e) - 1 : 0)) * 64 + (p)])
    {   const int dir = tid >> 8, co = (tid >> 4) & 15, ci = tid & 15;
        float acc[32];
#pragma unroll
        for (int i = 0; i < 32; ++i) acc[i] = 0.f;
#pragma unroll 1
        for (int p = 0; p < 64; ++p) { const f32x2v w = cmul(CC[(dir * 16 + co) * 64 + p], BB[(dir * 64 + p) * 16 + ci]);
            acc[0] += w.x;
#pragma unroll
            for (int lag = 1; lag < 32; ++lag) { const f32x2v pw = PW[(dir * 32 + lag - 1) * 64 + p]; acc[lag] += w.x * pw.x - w.y * pw.y; } }
#pragma unroll
        for (int lag = 0; lag < 32; ++lag) KT[(dir * 32 + lag) * 256 + co * 16 + ci] = acc[lag];
    }
    __syncthreads();
    {   bf16* W = WY + (size_t)g * 512 * KX; const float* Dk = IN(12) + (size_t)l * SW + g * SG;
#pragma unroll 1
        for (int v = tid; v < 512 * 96; v += NWAVES * 64) { const int n = v / 96, kv = v % 96, i = n >> 4, co = n & 15, k0 = 8 * kv;
            float val[8];
            if (k0 < 512) { const int j = k0 >> 4, ci0 = k0 & 15;
                if (j < i) {
#pragma unroll
                    for (int e = 0; e < 8; ++e) val[e] = KT[(0 * 32 + (i - j)) * 256 + co * 16 + ci0 + e];
                } else if (j > i) {
#pragma unroll
                    for (int e = 0; e < 8; ++e) val[e] = KT[(1 * 32 + (j - i)) * 256 + co * 16 + ci0 + e];
                } else { const float dsk = Dk[co];
#pragma unroll
                    for (int e = 0; e < 8; ++e) val[e] = KT[co * 16 + ci0 + e] + KT[32 * 256 + co * 16 + ci0 + e] + ((ci0 + e == co) ? dsk : 0.f); }
            } else { const int q = k0 - 512, dir = q >> 7, comp = (q >> 6) & 1, p0 = q & 63; const int e_ = dir == 0 ? i + 1 : 32 - i;
#pragma unroll
                for (int e = 0; e < 8; ++e) { const f32x2v z = cmul(CC[(dir * 16 + co) * 64 + p0 + e], PW[(dir * 32 + e_ - 1) * 64 + p0 + e]); val[e] = comp == 0 ? z.x : -z.y; } }
            v4u o; o.x = pk2(val[0], val[1]); o.y = pk2(val[2], val[3]); o.z = pk2(val[4], val[5]); o.w = pk2(val[6], val[7]);
            *(v4u*)(W + (size_t)n * KX + k0) = o; }
    }
    {   bf16* B = BST + (size_t)g * 256 * 512;
#pragma unroll 1
        for (int v = tid; v < 256 * 64; v += NWAVES * 64) { const int n = v >> 6, kv = v & 63, dir = n >> 7, comp = (n >> 6) & 1, p = n & 63, j = kv >> 1, ci0 = (kv & 1) * 8;
            const int e_ = dir == 0 ? 31 - j : j; const f32x2v pw = PWR_(dir, e_, p);
            float val[8];
#pragma unroll
            for (int e = 0; e < 8; ++e) { const f32x2v z = cmul(pw, BB[(dir * 64 + p) * 16 + ci0 + e]); val[e] = comp == 0 ? z.x : z.y; }
            v4u o; o.x = pk2(val[0], val[1]); o.y = pk2(val[2], val[3]); o.z = pk2(val[4], val[5]); o.w = pk2(val[6], val[7]);
            *(v4u*)(B + (size_t)n * 512 + 8 * kv) = o; }
    }
#undef PWR_
    __syncthreads();
}
__device__ __forceinline__ void ssm_scan_coop(int l, const float* S  , bf16* UX  , LAS unsigned char* lds, int vcu, int G, int wave) {
    const int lane = opaque_tid() & 63;
    const int seg = wave & 3, slot = wave >> 2;
    LAS float* T = (LAS float*)lds;
    for (int it0 = vcu; it0 < NG * BATCH * 2; it0 += 2 * G) {
        const int it = it0 + slot * G; const bool act = it < NG * BATCH * 2;
        const int itc = act ? it : it0;
        const int dir = itc & 1, b = (itc >> 1) & 3, g = itc >> 3;
        const size_t gi = ((size_t)l * 2 + dir) * NG + g;
        const float step = __expf(IN(7)[gi]); const float lr = IN(5)[gi * SP + lane], li = IN(6)[gi * SP + lane];
        float sn, cs; const float mag = __expf(lr * step * (float)CH); sincosf(li * step * (float)CH, &sn, &cs);
        const float ar = mag * cs, ai = mag * sn;
        const float magS = __expf(lr * step * (float)(CH * 64)); float snS, csS; sincosf(li * step * (float)(CH * 64), &snS, &csS);
        const float Ar = magS * csS, Ai = magS * snS;
        const size_t row0 = (size_t)g * NCHUNK + (size_t)b * CPS;
        const float* Sp = S + row0 * 256 + dir * 128 + lane; bf16* Xp = UX + row0 * KX + 512 + dir * 128 + lane;
        float sr[64], si[64];
#pragma unroll
        for (int k = 0; k < 64; ++k) { const int cc = 64 * seg + k, c = dir ? (CPS - 1 - cc) : cc; sr[k] = Sp[(size_t)c * 256]; si[k] = Sp[(size_t)c * 256 + 64]; }
        float er = 0.f, ei = 0.f;
#pragma unroll
        for (int k = 0; k < 64; ++k) { const float nr = ar * er - ai * ei + sr[k], ni = ar * ei + ai * er + si[k]; er = nr; ei = ni; }
        T[((slot * 4 + seg) * 2 + 0) * 64 + lane] = er; T[((slot * 4 + seg) * 2 + 1) * 64 + lane] = ei;
        __syncthreads();
        er = 0.f; ei = 0.f;
        for (int q = 0; q < seg; ++q) { const float tr = T[((slot * 4 + q) * 2 + 0) * 64 + lane], ti = T[((slot * 4 + q) * 2 + 1) * 64 + lane];
            const float nr = Ar * er - Ai * ei + tr, ni = Ar * ei + Ai * er + ti; er = nr; ei = ni; }
        if (act) {
#pragma unroll
            for (int k = 0; k < 64; ++k) { const int cc = 64 * seg + k, c = dir ? (CPS - 1 - cc) : cc;
                Xp[(size_t)c * KX] = (bf16)f2bf(er); Xp[(size_t)c * KX + 64] = (bf16)f2bf(ei);
                const float nr = ar * er - ai * ei + sr[k], ni = ar * ei + ai * er + si[k]; er = nr; ei = ni; } }
        __syncthreads();
    }
}

__global__ void __launch_bounds__(NWAVES * 64, 2) mega_fwd(Ptrs P_unused) {
    extern __shared__ __attribute__((aligned(16))) unsigned char lds_raw[];
    LAS unsigned char* lds = (LAS unsigned char*)lds_raw;
    const int tid = threadIdx.x, wave = __builtin_amdgcn_readfirstlane(tid >> 6);
    const int G = gridDim.x;
    const int vcu = (G % 8 == 0) ? ((int)blockIdx.x % 8) * (G / 8) + (int)blockIdx.x / 8 : (int)blockIdx.x;
    const int gw = vcu * NWAVES + wave, ngw = G * NWAVES;
    for (int u = tid; u < (LDS_BYTES - LDSCTL_OFF) / 4; u += NWAVES * 64) ((LAS unsigned*)(lds + LDSCTL_OFF))[u] = 0u;
    __syncthreads();
    (void)xcd_barrier_post(WSB(unsigned, WS_CTL) + CW_BAR, (volatile LAS unsigned*)(lds + MISC_OFF) + 8);
#define GRID_BAR() do { XcdBarrier b_; b_.bar = WSB(unsigned, WS_CTL) + CW_BAR; b_.x = xb_xcc_id(); b_.st = (volatile LAS unsigned*)(lds + MISC_OFF) + 8; xcd_barrier(b_); } while (0)

    p0_mods(lds, wave);
    __syncthreads();
    p0_weights(lds, gw, ngw, wave);
    __syncthreads();
    for (int it = vcu; it < DEPTH * NG; it += G) ssm_prep_item(it / NG, it % NG, lds, WSB(bf16, WS_BST) + (size_t)(it / NG) * NG * 256 * 512, WSB(bf16, WS_WY) + (size_t)(it / NG) * NG * 512 * KX);
    GRID_BAR();
    row_mod_pass(IN(0), WSB(bf16, WS_H), WSB(bf16, WS_YB), WSB(float, WS_MODS), 0 * DM, 1 * DM, gw, ngw);
    GRID_BAR();

#pragma unroll 1
    for (int l = 0; l < DEPTH; ++l) {
        { pg8::Gemm g = pg8::gemm_rm(WSB(bf16, WS_H), WSB(bf16, WS_WIN) + (size_t)l * INW * DM, DM); pg8::StaticOrder S; S.init(M, INW, G, (int)blockIdx.x);
          pg8::EpiQKVU E{WSB(bf16, WS_QKV), (size_t)M * AW, at3::QSCALE, WSB(bf16, WS_UX), NCHUNK};
          pg8::gemm_phase<pg8::EpiQKVU, pg8::StaticOrder, true, true>(lds + RING_OFF, g, S, E); }
        GRID_BAR();
        { pg8::Gemm g{WSB(bf16, WS_UX), WSB(bf16, WS_BST) + (size_t)l * NG * 256 * 512, 512, KX, 16, 512}; pg8::GroupOrder S; S.init(NG, 4, 1, G, vcu);
          pg8::EpiStateF32 E{WSB(float, WS_S)};
          pg8::gemm_phase<pg8::EpiStateF32, pg8::GroupOrder, true, true>(lds + RING_OFF, g, S, E); }
        GRID_BAR();
        ssm_scan_coop(l, WSB(float, WS_S), WSB(bf16, WS_UX), lds + RING_OFF, vcu, G, wave);
        __syncthreads();
        at3::attn_phase(WSB(bf16, WS_QKV), WSB(bf16, WS_QKV) + (size_t)M * AW, WSB(bf16, WS_QKV) + (size_t)2 * M * AW, WSB(bf16, WS_MRG), WSB(float, WS_SSQP), lds + RING_OFF, vcu, G, wave);
        GRID_BAR();
        { pg8::Gemm g{WSB(bf16, WS_UX), WSB(bf16, WS_WY) + (size_t)l * NG * 512 * KX, KX, KX, 16, KX}; pg8::GroupOrder S; S.init(NG, 4, 2, G, vcu);
          pg8::EpiSsmY E{WSB(bf16, WS_YACT)};
          pg8::gemm_phase<pg8::EpiSsmY, pg8::GroupOrder, true, true>(lds + RING_OFF, g, S, E); }
        GRID_BAR();
        { pg8::Gemm g{WSB(bf16, WS_YACT), WSB(bf16, WS_WGLU) + (size_t)l * SW * SW, SW, 16, M * 16, SW}; pg8::StaticOrder S; S.init(M, SW, G, (int)blockIdx.x);
          pg8::EpiGluG E{WSB(bf16, WS_YACT), (size_t)M * 16, WSB(bf16, WS_MRG), DM, AW, IN(14) + (size_t)l * SW, WSB(float, WS_SSQP) + (size_t)M * 16};
          pg8::gemm_phase<pg8::EpiGluG, pg8::StaticOrder, true, true>(lds + RING_OFF, g, S, E); }
        GRID_BAR();
        row_factor_pass(WSB(float, WS_SSQP), WSB(float, WS_RF), vcu * NWAVES * 64, G * NWAVES * 64);
        GRID_BAR();
        { pg8::Gemm g = pg8::gemm_rm(WSB(bf16, WS_MRG), WSB(bf16, WS_WOUT) + (size_t)l * DM * DM, DM); pg8::StaticOrder S; S.init(M, DM, G, (int)blockIdx.x);
          pg8::EpiResidT<true> E{l, 0, WS_MODS, WS_STATS, WS_YB, WS_RF, DM, NMOD, SEQ, ALPHA, WS_LNCNT, lds + RING_OFF + pg8::STAGE_BYTES};
          pg8::gemm_phase<pg8::EpiResidT<true>, pg8::StaticOrder, true, true>(lds + RING_OFF, g, S, E); }
        ln_queue_pass(lds, l * 2, WSB(bf16, WS_YB), WSB(bf16, WS_H), nullptr, WSB(float, WS_STATS), IN(18) + (size_t)l * DM, IN(19) + (size_t)l * DM, WSB(float, WS_MODS) + (size_t)l * BATCH * NMOD, 3 * DM, 4 * DM, G);
        GRID_BAR();
        { pg8::Gemm g = pg8::gemm_rm(WSB(bf16, WS_H), WSB(bf16, WS_W1) + (size_t)l * FF * DM, DM); pg8::StaticOrder S; S.init(M, FF, G, (int)blockIdx.x);
          pg8::EpiBf16<2> E{WSB(bf16, WS_HID), FF, 0, 0, 1.f};
          pg8::gemm_phase<pg8::EpiBf16<2>, pg8::StaticOrder, true, true>(lds + RING_OFF, g, S, E); }
        GRID_BAR();
        { pg8::Gemm g = pg8::gemm_rm(WSB(bf16, WS_HID), WSB(bf16, WS_W2) + (size_t)l * DM * FF, FF); pg8::StaticOrder S; S.init(M, DM, G, (int)blockIdx.x);
          pg8::EpiResidT<false> E{l, 1, WS_MODS, WS_STATS, WS_YB, WS_RF, DM, NMOD, SEQ, ALPHA, WS_LNCNT, lds + RING_OFF + pg8::STAGE_BYTES};
          pg8::gemm_phase<pg8::EpiResidT<false>, pg8::StaticOrder, true, true>(lds + RING_OFF, g, S, E); }
        ln_queue_pass(lds, l * 2 + 1, WSB(bf16, WS_YB), WSB(bf16, WS_H), (l + 1 == DEPTH) ? OUTP() : nullptr, WSB(float, WS_STATS), IN(22) + (size_t)l * DM, IN(23) + (size_t)l * DM, (l + 1 < DEPTH) ? WSB(float, WS_MODS) + (size_t)(l + 1) * BATCH * NMOD : nullptr, 0 * DM, 1 * DM, G);
        GRID_BAR();
    }
}

extern "C" void kernel_launch(void* const* d_in, const int* in_sizes, int n_in, void* d_out, int out_size, void* d_ws, size_t ws_size, hipStream_t stream) {
    static int grid = 0;
    if (grid == 0) {
        if (n_in != 24 || out_size != M * DM || ws_size < WS_END) { fprintf(stderr, "kernel_launch: unexpected shapes (n_in %d out %d ws %zu)\n", n_in, out_size, ws_size); grid = -1; return; }
        int dev = 0, cus = 0, per_cu = 0;
        if (hipGetDevice(&dev) != hipSuccess || hipDeviceGetAttribute(&cus, hipDeviceAttributeMultiprocessorCount, dev) != hipSuccess) { grid = -1; return; }
        if (hipFuncSetAttribute((const void*)mega_fwd, hipFuncAttributeMaxDynamicSharedMemorySize, LDS_BYTES) != hipSuccess) { fprintf(stderr, "kernel_launch: hipFuncSetAttribute failed\n"); grid = -1; return; }
        if (hipOccupancyMaxActiveBlocksPerMultiprocessor(&per_cu, (const void*)mega_fwd, NWAVES * 64, LDS_BYTES) != hipSuccess || per_cu < 1)
            fprintf(stderr, "kernel_launch: note: occupancy query reports %d workgroups per CU\n", per_cu);
        (void)hipGetLastError();
        grid = cus;
    }
    if (grid < 0) return;
    if (hipMemsetAsync((char*)d_ws + WS_CTL, 0, CTL_ZERO_BYTES, stream) != hipSuccess) return;
    Ptrs p{};
    for (int i = 0; i < 24; ++i) p.in[i] = (const float*)d_in[i];
    p.out = (float*)d_out; p.ws = (unsigned char*)d_ws;
    hipLaunchKernelGGL(mega_fwd, dim3(grid), dim3(NWAVES * 64), LDS_BYTES, stream, p);
}
```

```cpp
#include <hip/hip_runtime.h>
#include <cstdio>
#include <cstdint>
#define GAS __attribute__((address_space(1)))
typedef const __attribute__((address_space(4))) unsigned long long* kargp_t;
__device__ __forceinline__ kargp_t karg() { kargp_t kp = (kargp_t)__builtin_amdgcn_kernarg_segment_ptr(); asm volatile("" : "+s"(kp)); return kp; }
__device__ __forceinline__ const float* IN(int i) { return (const float*)(const GAS float*)karg()[i]; }
__device__ __forceinline__ float* OUTP() { return (float*)(GAS float*)karg()[24]; }
__device__ __forceinline__ unsigned char* WSP() { return (unsigned char*)(GAS unsigned char*)karg()[25]; }
#define WSB(T, off) ((T*)(WSP() + (off)))
__device__ __forceinline__ float fsum_x16x32(float v) {
    { auto r = __builtin_amdgcn_permlane16_swap(__float_as_uint(v), __float_as_uint(v), false, false); v = __uint_as_float(r[0]) + __uint_as_float(r[1]); }
    { auto r = __builtin_amdgcn_permlane32_swap(__float_as_uint(v), __float_as_uint(v), false, false); v = __uint_as_float(r[0]) + __uint_as_float(r[1]); }
    return v;
}
namespace pg8 {
#define PG8_LAS __attribute__((address_space(3)))
typedef unsigned short bf16_t;
typedef short bf16x8 __attribute__((ext_vector_type(8)));
typedef float f32x4 __attribute__((ext_vector_type(4)));
typedef unsigned u32x4 __attribute__((ext_vector_type(4)));
constexpr int BM = 256, BK = 64, HALF = 128, HTB = HALF * BK * 2  , STAGE_BYTES = 8 * HTB, NXCD = 8;

__host__ __device__ __forceinline__ int lds_byte(int r, int c) { const int st = (r >> 4) * 2 + (c >> 5), rr = r & 15, cc = c & 31, ob = rr * 64 + cc * 2; return st * 1024 + (ob ^ (((ob >> 9) & 1) << 5)); }
__host__ __device__ __forceinline__ void stage_rc(int b, int& R, int& C) { const int st = b / 1024, sb = b % 1024, swz = sb ^ (((sb >> 9) & 1) << 5); R = (st >> 1) * 16 + swz / 64; C = (st & 1) * 32 + (swz % 64) / 2; }
__host__ __device__ __forceinline__ int perm32(int rho) { const int n = rho >> 4, i = rho & 15; return 8 * (i >> 2) + 4 * n + (i & 3); }

struct Unit { int pm, pn; };
struct Gemm { const bf16_t* A; const bf16_t* Bt; int K; int ars, aks, ldb; };
__host__ __device__ __forceinline__ Gemm gemm_rm(const bf16_t* A, const bf16_t* Bt, int K) { return Gemm{A, Bt, K, K, 16, K}; }

struct StaticOrder {
    int nM, nN, nwg, G, c, WGM;
    __host__ __device__ void init(int M, int N, int G_, int c_, int wgm = 4) { nM = M / BM; nN = N / BM; nwg = nM * nN; G = G_; c = c_; WGM = wgm; }
    __host__ __device__ bool next(int i, Unit& u) const {
        const long L = (long)i * G + c; if (L >= nwg) return false;
        int wgid = (int)L; { const int q = nwg / NXCD, r = nwg % NXCD, xcd = wgid % NXCD, off = wgid / NXCD; wgid = (xcd < r ? xcd * (q + 1) : r * (q + 1) + (xcd - r) * q) + off; }
        const int nig = WGM * nN, gid = wgid / nig, fm = gid * WGM, gsz = (nM - fm) < WGM ? (nM - fm) : WGM;
        u.pm = fm + ((wgid % nig) % gsz); u.pn = (wgid % nig) / gsz; return true;
    }
    __device__ __forceinline__ void a_ready(const Unit&) const {}
    __device__ __forceinline__ void done(const Unit&) const {}
};

__device__ __forceinline__ unsigned cvt_pk_bf16(float lo, float hi) { unsigned r; asm volatile("v_cvt_pk_bf16_f32 %0, %1, %2" : "=v"(r) : "v"(lo), "v"(hi)); return r; }
typedef float f32x2 __attribute__((ext_vector_type(2)));
template <class E> struct perm2_of { static constexpr bool v = false; };
template <int DPPC> __device__ __forceinline__ u32x4 dpp4(const u32x4& x) { u32x4 r; r.x = (unsigned)__builtin_amdgcn_update_dpp(0, (int)x.x, DPPC, 0xF, 0xF, true); r.y = (unsigned)__builtin_amdgcn_update_dpp(0, (int)x.y, DPPC, 0xF, 0xF, true);
    r.z = (unsigned)__builtin_amdgcn_update_dpp(0, (int)x.z, DPPC, 0xF, 0xF, true); r.w = (unsigned)__builtin_amdgcn_update_dpp(0, (int)x.w, DPPC, 0xF, 0xF, true); return r; }
__device__ __forceinline__ u32x4 sel4(bool c, const u32x4& a, const u32x4& b) { u32x4 r; r.x = c ? a.x : b.x; r.y = c ? a.y : b.y; r.z = c ? a.z : b.z; r.w = c ? a.w : b.w; return r; }
template <int ACT> struct EpiBf16 {
    static constexpr bool PERM = true, AFTER_DRAIN = false; static constexpr bool MIDK = false;
    bf16_t* O; int ldc; int split_cols; size_t split_stride; float scale0;
    __device__ __forceinline__ void operator()(const f32x4 (&acc)[2][2][4][2], const Unit& u, int wr, int wc, int fr, int fq) const {
        const int row0 = u.pm * BM + wr * 64 + fr; int colt = u.pn * BM; bf16_t* base = O;
        float sc = 1.f; if (split_cols) { const int t = colt / split_cols; base += (size_t)t * split_stride; colt -= t * split_cols; if (t == 0) sc = scale0; }
        if constexpr (ACT == 2) {
            const bool even = (fr & 1) == 0;
            const int colA = colt + wc * 64 + 8 * fq + (even ? 0 : 32);
            const long offA = (long)(row0 - (even ? 0 : 1)) * ldc + colA, offB = (long)(row0 + (even ? 1 : 0)) * ldc + colA;
#pragma unroll
            for (int ai = 0; ai < 2; ++ai)
#pragma unroll
                for (int m = 0; m < 4; ++m) { u32x4 w[2];
#pragma unroll
                    for (int bj = 0; bj < 2; ++bj) { f32x4 v0 = acc[ai][bj][m][0], v1 = acc[ai][bj][m][1];
#pragma unroll
                        for (int e = 0; e < 4; ++e) { const float a = fmaxf(v0[e], 0.f), b = fmaxf(v1[e], 0.f); v0[e] = a * a; v1[e] = b * b; }
                        v0 = v0 * sc; v1 = v1 * sc; w[bj].x = cvt_pk_bf16(v0[0], v0[1]); w[bj].y = cvt_pk_bf16(v0[2], v0[3]); w[bj].z = cvt_pk_bf16(v1[0], v1[1]); w[bj].w = cvt_pk_bf16(v1[2], v1[3]); }
                    const u32x4 recv = dpp4<0xB1>(sel4(even, w[1], w[0]));
                    const size_t ro = (size_t)(ai * HALF + m * 16) * ldc;
                    *(u32x4*)(base + offA + ro) = sel4(even, w[0], recv);
                    *(u32x4*)(base + offB + ro) = sel4(even, recv, w[1]); }
        } else {
        const int col0 = colt + wc * 32 + 8 * fq;
#pragma unroll
        for (int ai = 0; ai < 2; ++ai)
#pragma unroll
            for (int m = 0; m < 4; ++m) { bf16_t* rowp = base + (size_t)(row0 + ai * HALF + m * 16) * ldc + col0;
#pragma unroll
                for (int bj = 0; bj < 2; ++bj) { f32x4 v0 = acc[ai][bj][m][0], v1 = acc[ai][bj][m][1];
                    v0 = v0 * sc; v1 = v1 * sc; u32x4 w; w.x = cvt_pk_bf16(v0[0], v0[1]); w.y = cvt_pk_bf16(v0[2], v0[3]); w.z = cvt_pk_bf16(v1[0], v1[1]); w.w = cvt_pk_bf16(v1[2], v1[3]);
                    *(u32x4*)(rowp + bj * HALF) = w; } }
        }
    }
};
template <> struct perm2_of<EpiBf16<2>> { static constexpr bool v = true; };
__device__ __forceinline__ float bf_lo(unsigned w) { return __uint_as_float(w << 16); }
__device__ __forceinline__ float bf_hi(unsigned w) { return __uint_as_float(w & 0xffff0000u); }
typedef _Float16 f16x8 __attribute__((ext_vector_type(8)));
__device__ __forceinline__ u32x4 pack_f16x8(const f32x4& a, const f32x4& b) { f16x8 h = {(_Float16)a[0], (_Float16)a[1], (_Float16)a[2], (_Float16)a[3], (_Float16)b[0], (_Float16)b[1], (_Float16)b[2], (_Float16)b[3]}; return __builtin_bit_cast(u32x4, h); }
__device__ __forceinline__ void unpack_f16x8(const u32x4& w, f32x4& a, f32x4& b) { const f16x8 h = __builtin_bit_cast(f16x8, w); a = (f32x4){(float)h[0], (float)h[1], (float)h[2], (float)h[3]}; b = (f32x4){(float)h[4], (float)h[5], (float)h[6], (float)h[7]}; }
template <bool MIX> struct EpiResidT {
    static constexpr bool PERM = true, AFTER_DRAIN = false; static constexpr bool MIDK = MIX;
    int l, sub;
    size_t mods_off, stats_off, yb_off, ssq_off; int ldc, gstride, rows_per_batch; float alpha;
    size_t cnt_off;
    __device__ __forceinline__ void midk(f32x4 (&acc)[2][2][4][2], const Unit& u, int wr, int wc, int fr, int fq) const {
        const f32x2* rf = (const f32x2*)(WSP() + ssq_off); const int row0 = u.pm * BM + wr * 64 + fr;
        float ratio[8];
#pragma unroll
        for (int i = 0; i < 8; ++i) ratio[i] = rf[row0 + (i >> 2) * HALF + (i & 3) * 16].x;
#pragma unroll
        for (int i = 0; i < 8; ++i)
#pragma unroll
            for (int bj = 0; bj < 2; ++bj)
#pragma unroll
                for (int n = 0; n < 2; ++n) acc[i >> 2][bj][i & 3][n] = acc[i >> 2][bj][i & 3][n] * ratio[i];
    }
    __device__ __forceinline__ void count_in(const Unit& u) const {
        if (threadIdx.x == 0) __hip_atomic_fetch_add((GAS unsigned*)(WSP() + cnt_off) + (l * 2 + sub) * 128 + u.pm, 1u, __ATOMIC_RELAXED, __HIP_MEMORY_SCOPE_AGENT); }
    __device__ __forceinline__ void operator()(const f32x4 (&acc)[2][2][4][2], const Unit& u, int wr, int wc, int fr, int fq) const {
        const int row0 = u.pm * BM + wr * 64 + fr, col0 = u.pn * BM + wc * 32 + 8 * fq;
        const int b = (u.pm * BM) / rows_per_batch;
        const bool first = (l == 0 && sub == 0);
        bf16_t* YB = (bf16_t*)(WSP() + yb_off);
        const float* gate = (const float*)(WSP() + mods_off) + (size_t)l * 4 * gstride + (sub == 0 ? 2 : 5) * ldc;
        const float* stats = (const float*)(WSP() + stats_off);
        const int ll = sub == 0 ? (l > 0 ? l - 1 : 0) : l;
        const float* lg = IN(sub == 0 ? 22 : 18) + (size_t)ll * ldc; const float* lb = IN(sub == 0 ? 23 : 19) + (size_t)ll * ldc;
        f32x4 gv[2][2], gm[2][2], bt[2][2];
#pragma unroll
        for (int bj = 0; bj < 2; ++bj)
#pragma unroll
            for (int n = 0; n < 2; ++n) { gv[bj][n] = *(const f32x4*)(gate + (size_t)b * gstride + col0 + bj * HALF + n * 4) + 1.0f;
                if (!first) { gm[bj][n] = *(const f32x4*)(lg + col0 + bj * HALF + n * 4) * alpha; bt[bj][n] = *(const f32x4*)(lb + col0 + bj * HALF + n * 4) * alpha; }
                else { gm[bj][n] = (f32x4){alpha, alpha, alpha, alpha}; bt[bj][n] = (f32x4){0.f, 0.f, 0.f, 0.f}; } }
        const bf16_t* __restrict__ Yr = YB; bf16_t* __restrict__ Yw = YB;
#pragma unroll
        for (int aq = 0; aq < 4; ++aq) { const int ai = aq >> 1, mb_ = (aq & 1) * 2;
            f32x4 xv[2][2][2]; float mean[2], rstd[2], rsm[2];
            { u32x4 w[2][2];
#pragma unroll
                for (int mm = 0; mm < 2; ++mm) { const int r = row0 + ai * HALF + (mb_ + mm) * 16; const size_t off = (size_t)r * ldc + col0;
                    mean[mm] = 0.f; rstd[mm] = 1.f; if (!first) { const f32x2 st = *(const f32x2*)(stats + 2 * (size_t)r); mean[mm] = st.x; rstd[mm] = st.y; }
                    rsm[mm] = 1.f; if constexpr (MIX) rsm[mm] = ((const f32x2*)(WSP() + ssq_off))[r].y;
#pragma unroll
                    for (int bj = 0; bj < 2; ++bj) w[mm][bj] = *(const u32x4*)(Yr + off + bj * HALF); }
#pragma unroll
                for (int mm = 0; mm < 2; ++mm)
#pragma unroll
                    for (int bj = 0; bj < 2; ++bj) unpack_f16x8(w[mm][bj], xv[mm][bj][0], xv[mm][bj][1]); }
#pragma unroll
            for (int mm = 0; mm < 2; ++mm) { const int m = mb_ + mm; const int r = row0 + ai * HALF + m * 16; const size_t off = (size_t)r * ldc + col0;
#pragma unroll
                for (int bj = 0; bj < 2; ++bj) { f32x4 y[2];
#pragma unroll
                    for (int n = 0; n < 2; ++n) y[n] = ((xv[mm][bj][n] - mean[mm]) * rstd[mm]) * gm[bj][n] + bt[bj][n] + gv[bj][n] * (acc[ai][bj][m][n] * rsm[mm]);
                    { const u32x4 pk_ = pack_f16x8(y[0], y[1]); bf16_t* sp_ = Yw + off + bj * HALF;
                      asm volatile("global_store_dwordx4 %0, %1, off sc1\n\ts_nop 1" :: "v"(sp_), "v"(pk_) : "memory"); } } }
            asm volatile("" ::: "memory"); }
    }
};

template <class E> struct has_cnt { static constexpr bool v = false; };
template <bool MIX> struct has_cnt<EpiResidT<MIX>> { static constexpr bool v = true; };

struct EpiQKVU {
    static constexpr bool PERM = true, AFTER_DRAIN = false; static constexpr bool MIDK = false;
    bf16_t* O; size_t split_stride; float scale0; bf16_t* UX; int nchunk;
    __device__ __forceinline__ void operator()(const f32x4 (&acc)[2][2][4][2], const Unit& u, int wr, int wc, int fr, int fq) const {
        const int row0 = u.pm * BM + wr * 64 + fr; const int t = (u.pn * BM) >> 10; const int colt = (u.pn * BM) & 1023;
        const float sc = (t == 0) ? scale0 : 1.f;
        const int col0 = colt + wc * 32 + 8 * fq;
#pragma unroll
        for (int ai = 0; ai < 2; ++ai)
#pragma unroll
            for (int m = 0; m < 4; ++m) { const int r = row0 + ai * HALF + m * 16;
#pragma unroll
                for (int bj = 0; bj < 2; ++bj) { f32x4 v0 = acc[ai][bj][m][0] * sc, v1 = acc[ai][bj][m][1] * sc;
                    u32x4 w; w.x = cvt_pk_bf16(v0[0], v0[1]); w.y = cvt_pk_bf16(v0[2], v0[3]); w.z = cvt_pk_bf16(v1[0], v1[1]); w.w = cvt_pk_bf16(v1[2], v1[3]);
                    const int col = col0 + bj * HALF;
                    bf16_t* p = (t == 0) ? O + (size_t)r * 1024 + col
                              : (t < 3) ? O + (size_t)t * split_stride + ((size_t)(col >> 6) * (split_stride >> 10) + r) * 64 + (col & 63)
                                        : UX + ((size_t)(col >> 4) * nchunk + (r >> 5)) * 768 + (r & 31) * 16 + (col & 15);
                    *(u32x4*)p = w; } }
    }
};
struct EpiStateF32 {
    static constexpr bool PERM = false, AFTER_DRAIN = false; static constexpr bool MIDK = false;
    float* C;
    __device__ __forceinline__ void operator()(const f32x4 (&acc)[2][2][4][2], const Unit& u, int wr, int wc, int fr, int fq) const {
        const int row0 = u.pm * BM + wr * 64 + fr, col0 = wc * 32 + 4 * fq;
#pragma unroll
        for (int ai = 0; ai < 2; ++ai)
#pragma unroll
            for (int m = 0; m < 4; ++m) { float* rowp = C + (size_t)(row0 + ai * HALF + m * 16) * 256 + col0;
#pragma unroll
                for (int bj = 0; bj < 2; ++bj)
#pragma unroll
                    for (int n = 0; n < 2; ++n) *(f32x4*)(rowp + bj * HALF + n * 16) = acc[ai][bj][m][n]; }
    }
};
__device__ __forceinline__ float gelu_tanh_f(float x) { const float z = 0.7978845608028654f * (x + 0.044715f * x * x * x); return x * __builtin_amdgcn_rcpf(1.f + __expf(-2.f * z)); }
struct EpiSsmY {
    static constexpr bool PERM = true, AFTER_DRAIN = false; static constexpr bool MIDK = false;
    bf16_t* O;
    __device__ __forceinline__ void operator()(const f32x4 (&acc)[2][2][4][2], const Unit& u, int wr, int wc, int fr, int fq) const {
        const int row0 = u.pm * BM + wr * 64 + fr, col0 = (u.pn & 1) * BM + wc * 32 + 8 * fq;
#pragma unroll
        for (int ai = 0; ai < 2; ++ai)
#pragma unroll
            for (int m = 0; m < 4; ++m) { bf16_t* rowp = O + (size_t)(row0 + ai * HALF + m * 16) * 512 + col0;
#pragma unroll
                for (int bj = 0; bj < 2; ++bj) { const f32x4 v0 = acc[ai][bj][m][0], v1 = acc[ai][bj][m][1];
                    u32x4 w; w.x = cvt_pk_bf16(gelu_tanh_f(v0[0]), gelu_tanh_f(v0[1])); w.y = cvt_pk_bf16(gelu_tanh_f(v0[2]), gelu_tanh_f(v0[3]));
                    w.z = cvt_pk_bf16(gelu_tanh_f(v1[0]), gelu_tanh_f(v1[1])); w.w = cvt_pk_bf16(gelu_tanh_f(v1[2]), gelu_tanh_f(v1[3]));
                    *(u32x4*)(rowp + bj * HALF) = w; } }
    }
};
struct EpiGluG {
    static constexpr bool PERM = true, AFTER_DRAIN = false; static constexpr bool MIDK = false;
    const bf16_t* S; size_t gstride; bf16_t* O; int ldo; int ocol; const float* bias; float* ssq;
    __device__ __forceinline__ void operator()(const f32x4 (&acc)[2][2][4][2], const Unit& u, int wr, int wc, int fr, int fq) const {
        const int row0 = u.pm * BM + wr * 64 + fr; const int col0 = u.pn * BM + wc * 32 + 8 * fq;
        f32x4 bv[2][2];
#pragma unroll
        for (int bj = 0; bj < 2; ++bj)
#pragma unroll
            for (int n = 0; n < 2; ++n) bv[bj][n] = *(const f32x4*)(bias + col0 + bj * HALF + 4 * n);
        const bf16_t* __restrict__ Sr = S; bf16_t* __restrict__ Or = O;
#pragma unroll
        for (int ai = 0; ai < 2; ++ai) {
            u32x4 sv[4][2]; float sq[4] = {0.f, 0.f, 0.f, 0.f};
#pragma unroll
            for (int m = 0; m < 4; ++m) { const size_t r = (size_t)(row0 + ai * HALF + m * 16);
#pragma unroll
                for (int bj = 0; bj < 2; ++bj) { const int col = col0 + bj * HALF; sv[m][bj] = *(const u32x4*)(Sr + (size_t)(col >> 4) * gstride + r * 16 + (col & 15)); } }
#pragma unroll
            for (int m = 0; m < 4; ++m) { const size_t r = (size_t)(row0 + ai * HALF + m * 16);
#pragma unroll
                for (int bj = 0; bj < 2; ++bj) { const f32x4 z0 = acc[ai][bj][m][0] + bv[bj][0], z1 = acc[ai][bj][m][1] + bv[bj][1];
                    const int col = col0 + bj * HALF; const u32x4 w_ = sv[m][bj];
                    float s[8] = {bf_lo(w_.x), bf_hi(w_.x), bf_lo(w_.y), bf_hi(w_.y), bf_lo(w_.z), bf_hi(w_.z), bf_lo(w_.w), bf_hi(w_.w)};
                    float o[8];
#pragma unroll
                    for (int e = 0; e < 4; ++e) { o[e] = s[e] * __builtin_amdgcn_rcpf(1.f + __expf(-z0[e])); o[4 + e] = s[4 + e] * __builtin_amdgcn_rcpf(1.f + __expf(-z1[e])); }
                    u32x4 w; w.x = cvt_pk_bf16(o[0], o[1]); w.y = cvt_pk_bf16(o[2], o[3]); w.z = cvt_pk_bf16(o[4], o[5]); w.w = cvt_pk_bf16(o[6], o[7]);
#pragma unroll
                    for (int e2 = 0; e2 < 8; ++e2) sq[m] += o[e2] * o[e2];
                    *(u32x4*)(Or + r * ldo + ocol + col) = w; } }
#pragma unroll
            for (int m = 0; m < 4; ++m) { float q = sq[m]; q = fsum_x16x32(q);
                if (fq == 0) ssq[(size_t)(row0 + ai * HALF + m * 16) * 16 + 4 * u.pn + wc] = q; }
            asm volatile("" ::: "memory"); }
    }
};
struct GroupOrder {
    int nMg, nNg, nwg, G, c;
    __host__ __device__ void init(int ngroups, int nMg_, int nNg_, int G_, int c_) { nMg = nMg_; nNg = nNg_; nwg = ngroups * nMg_ * nNg_; G = G_; c = c_; }
    __host__ __device__ bool next(int i, Unit& u) const {
        const long L = (long)i * G + c; if (L >= nwg) return false;
        const int per = nMg * nNg, g = (int)L / per, r = (int)L % per;
        u.pm = g * nMg + r / nNg; u.pn = g * nNg + r % nNg; return true;
    }
    __device__ __forceinline__ void a_ready(const Unit&) const {}
    __device__ __forceinline__ void done(const Unit&) const {}
};

template <class Epi, class Sched, bool ALIGN_EPI = false, bool SP2 = false>
__device__ __forceinline__ void gemm_phase(PG8_LAS unsigned char* lds, const Gemm g, const Sched& S, const Epi& E) {
    int tid_ = threadIdx.x; asm volatile("" : "+v"(tid_));
    const int tid = tid_, wid = __builtin_amdgcn_readfirstlane(tid >> 6), lane = tid & 63, wr = wid >> 2, wc = wid & 3, fr = lane & 15, fq = lane >> 4;
    const int K = g.K, nt = K / BK;
    unsigned voffA[2], voffB[2];
#pragma unroll
    for (int i = 0; i < 2; ++i) { int R, C; stage_rc(tid * 16 + i * 8192, R, C); const int Rb = perm2_of<Epi>::v ? ((R >> 5) * 64 + perm32(R & 31)) : (Epi::PERM ? ((R & ~31) + perm32(R & 31)) : R);
        voffA[i] = (unsigned)(R * g.ars + (C >> 4) * g.aks + (C & 15)) * 2u; voffB[i] = (unsigned)(Rb * g.ldb + C) * 2u; }
    const size_t kstepA = (size_t)g.aks * 8, kstepB = (size_t)(BK * 2);
    const size_t hstepA = (size_t)HALF * g.ars * 2, hstepB = (size_t)(perm2_of<Epi>::v ? 32 : HALF) * g.ldb * 2;
    const size_t tstepA = 2 * hstepA, tstepB = (size_t)2 * HALF * g.ldb * 2;
    const unsigned ldsw = (unsigned)wid * 1024u;
    const int aoff = lds_byte(wr * 64 + fr, fq * 8), boff = lds_byte(wc * 32 + fr, fq * 8);
#define PG8_SA(b, h) (((b) * 2 + (h)) * HTB)
#define PG8_SB(b, h) ((4 + (b) * 2 + (h)) * HTB)
#define PG8_STAGE(bufoff, gbase, voff) do { _Pragma("unroll") for (int _i = 0; _i < 2; ++_i) \
        __builtin_amdgcn_global_load_lds((const unsigned*)((const char*)(gbase) + (voff)[_i]), (PG8_LAS unsigned*)(lds + (bufoff) + ldsw + _i * 8192), 16, 0, 0); } while (0)
#define PG8_LDA(dst, b, h) do { _Pragma("unroll") for (int m = 0; m < 4; ++m) _Pragma("unroll") for (int k = 0; k < 2; ++k) dst[m][k] = *(const PG8_LAS bf16x8*)(lds + PG8_SA(b, h) + aoff + m * 2048 + k * 1024); } while (0)
#define PG8_LDB(dst, b, h) do { _Pragma("unroll") for (int n = 0; n < 2; ++n) _Pragma("unroll") for (int k = 0; k < 2; ++k) dst[n][k] = *(const PG8_LAS bf16x8*)(lds + PG8_SB(b, h) + boff + n * 2048 + k * 1024); } while (0)
#define PG8_MMA(ai, bj, At, Bt) do { __builtin_amdgcn_s_setprio(1); _Pragma("unroll") for (int m = 0; m < 4; ++m) _Pragma("unroll") for (int n = 0; n < 2; ++n) _Pragma("unroll") for (int k = 0; k < 2; ++k) \
        acc[ai][bj][m][n] = __builtin_amdgcn_mfma_f32_16x16x32_bf16(Bt[n][k], At[m][k], acc[ai][bj][m][n], 0, 0, 0); __builtin_amdgcn_s_setprio(0); } while (0)
#define PG8_WAIT_V(n) asm volatile("s_waitcnt vmcnt(" #n ")" ::: "memory")
#define PG8_WAIT_L(n) asm volatile("s_waitcnt lgkmcnt(" #n ")" ::: "memory")
#define PG8_BAR __builtin_amdgcn_s_barrier()
#define PG8_SCHED __builtin_amdgcn_sched_barrier(0)
    Unit cur, nxt, prv; int ui = 0;
    if (!S.next(0, cur)) return;
    prv = cur;
    bf16x8 At[4][2], B0[2][2], B1[2][2];
    const char* cA = (const char*)g.A + (size_t)cur.pm * tstepA; const char* cB = (const char*)g.Bt + (size_t)cur.pn * tstepB;
    S.a_ready(cur);
    if constexpr (SP2) {
        PG8_STAGE(PG8_SB(0, 0), cB, voffB); PG8_STAGE(PG8_SB(0, 1), cB + hstepB, voffB); PG8_STAGE(PG8_SA(0, 0), cA, voffA); PG8_STAGE(PG8_SA(0, 1), cA + hstepA, voffA);
        if (wr == 1) PG8_BAR;
        PG8_WAIT_V(2); PG8_BAR;
        PG8_STAGE(PG8_SB(1, 0), cB + kstepB, voffB); PG8_STAGE(PG8_SA(1, 0), cA + kstepA, voffA); PG8_STAGE(PG8_SB(1, 1), cB + hstepB + kstepB, voffB);
        PG8_WAIT_V(6); PG8_BAR;
    } else {
        PG8_STAGE(PG8_SB(0, 0), cB, voffB); PG8_STAGE(PG8_SA(0, 0), cA, voffA); PG8_STAGE(PG8_SB(0, 1), cB + hstepB, voffB); PG8_STAGE(PG8_SA(0, 1), cA + hstepA, voffA);
        if (wr == 1) PG8_BAR;
        PG8_WAIT_V(4); PG8_BAR;
        PG8_STAGE(PG8_SB(1, 0), cB + kstepB, voffB); PG8_STAGE(PG8_SA(1, 0), cA + kstepA, voffA); PG8_STAGE(PG8_SB(1, 1), cB + hstepB + kstepB, voffB);
        PG8_WAIT_V(6); PG8_BAR;
    }
    for (;;) {
        const bool has_next = S.next(ui + 1, nxt);
        f32x4 acc[2][2][4][2];
#pragma unroll
        for (int a = 0; a < 2; ++a)
#pragma unroll
            for (int b = 0; b < 2; ++b)
#pragma unroll
                for (int m = 0; m < 4; ++m)
#pragma unroll
                    for (int n = 0; n < 2; ++n) acc[a][b][m][n] = (f32x4){0.f, 0.f, 0.f, 0.f};
        const char* nA = has_next ? (const char*)g.A + (size_t)nxt.pm * tstepA : cA; const char* nB = has_next ? (const char*)g.Bt + (size_t)nxt.pn * tstepB : cB;
#pragma unroll 1
        for (int kh = 0; kh < 2; ++kh) {
        for (int t = kh * (nt >> 1); t < (kh + 1) * (nt >> 1); t += 2) {
            const bool last = (t == nt - 2);
            const char* a1 = cA + (size_t)(t + 1) * kstepA;
            const char* a2 = last ? nA : cA + (size_t)(t + 2) * kstepA; const char* b2 = last ? nB : cB + (size_t)(t + 2) * kstepB;
            const char* a3 = a2 + kstepA; const char* b3 = b2 + kstepB;
            if (last && has_next) S.a_ready(nxt);
            if constexpr (SP2) {
            PG8_LDB(B0, 0, 0); PG8_LDB(B1, 0, 1); PG8_SCHED; PG8_LDA(At, 0, 0); PG8_STAGE(PG8_SA(1, 1), a1 + hstepA, voffA);
            PG8_WAIT_V(8); PG8_WAIT_L(0); PG8_BAR; PG8_MMA(0, 0, At, B0); PG8_MMA(0, 1, At, B1); PG8_BAR; PG8_SCHED;
            PG8_LDA(At, 0, 1); PG8_STAGE(PG8_SB(0, 0), b2, voffB); PG8_STAGE(PG8_SB(0, 1), b2 + hstepB, voffB); PG8_STAGE(PG8_SA(0, 0), a2, voffA);
            PG8_WAIT_V(8); PG8_WAIT_L(0); PG8_BAR; PG8_MMA(1, 0, At, B0); PG8_MMA(1, 1, At, B1); PG8_BAR; PG8_SCHED;
            PG8_LDB(B0, 1, 0); PG8_LDB(B1, 1, 1); PG8_SCHED; PG8_LDA(At, 1, 0); PG8_STAGE(PG8_SA(0, 1), a2 + hstepA, voffA);
            PG8_WAIT_V(8); PG8_WAIT_L(0); PG8_BAR; PG8_MMA(0, 0, At, B0); PG8_MMA(0, 1, At, B1); PG8_BAR; PG8_SCHED;
            PG8_LDA(At, 1, 1); PG8_STAGE(PG8_SB(1, 0), b3, voffB); PG8_STAGE(PG8_SB(1, 1), b3 + hstepB, voffB); PG8_STAGE(PG8_SA(1, 0), a3, voffA);
            PG8_WAIT_V(8); PG8_WAIT_L(0); PG8_BAR; PG8_MMA(1, 0, At, B0); PG8_MMA(1, 1, At, B1); PG8_BAR; PG8_SCHED;
            } else {
            PG8_LDB(B0, 0, 0); PG8_SCHED; PG8_LDA(At, 0, 0); PG8_STAGE(PG8_SA(1, 1), a1 + hstepA, voffA);
            PG8_WAIT_L(8); PG8_BAR; PG8_WAIT_L(0); PG8_MMA(0, 0, At, B0); PG8_BAR; PG8_SCHED;
            PG8_LDB(B1, 0, 1); PG8_STAGE(PG8_SB(0, 0), b2, voffB);
            PG8_BAR; PG8_WAIT_L(0); PG8_MMA(0, 1, At, B1); PG8_BAR;
            PG8_LDA(At, 0, 1); PG8_STAGE(PG8_SA(0, 0), a2, voffA);
            PG8_BAR; PG8_WAIT_L(0); PG8_MMA(1, 0, At, B0); PG8_BAR; PG8_SCHED;
            PG8_STAGE(PG8_SB(0, 1), b2 + hstepB, voffB);
            PG8_WAIT_V(6); PG8_BAR; PG8_MMA(1, 1, At, B1); PG8_BAR;
            PG8_LDB(B0, 1, 0); PG8_SCHED; PG8_LDA(At, 1, 0); PG8_STAGE(PG8_SA(0, 1), a2 + hstepA, voffA);
            PG8_WAIT_L(8); PG8_BAR; PG8_WAIT_L(0); PG8_MMA(0, 0, At, B0); PG8_BAR; PG8_SCHED;
            PG8_LDB(B1, 1, 1); PG8_STAGE(PG8_SB(1, 0), b3, voffB);
            PG8_BAR; PG8_WAIT_L(0); PG8_MMA(0, 1, At, B1); PG8_BAR;
            PG8_LDA(At, 1, 1); PG8_STAGE(PG8_SA(1, 0), a3, voffA);
            PG8_BAR; PG8_WAIT_L(0); PG8_MMA(1, 0, At, B0); PG8_BAR; PG8_SCHED;
            PG8_STAGE(PG8_SB(1, 1), b3 + hstepB, voffB);
            PG8_WAIT_V(6); PG8_BAR; PG8_MMA(1, 1, At, B1); PG8_BAR;
            }
        }
        if constexpr (Epi::MIDK) { if (kh == 0) E.midk(acc, cur, wr, wc, fr, fq); }
        }
        if constexpr (ALIGN_EPI) { if (wr == 0) PG8_BAR; }
        if constexpr (has_cnt<Epi>::v) { if (ui > 0) E.count_in(prv); prv = cur; }
        if constexpr (!Epi::AFTER_DRAIN) { E(acc, cur, wr, wc, fr, fq); S.done(cur); }
        if (!has_next) break;
        cur = nxt; cA = nA; cB = nB; ++ui;
        if constexpr (ALIGN_EPI) { if (wr == 1) PG8_BAR; }
    }
    PG8_WAIT_V(0);
    if constexpr (!ALIGN_EPI) { if (wr == 0) PG8_BAR; }
    PG8_BAR;
    if constexpr (has_cnt<Epi>::v) E.count_in(cur);
    static_assert(!Epi::AFTER_DRAIN, "after-drain epilogues are not supported by this body");
#undef PG8_SA
#undef PG8_SB
#undef PG8_STAGE
#undef PG8_LDA
#undef PG8_LDB
#undef PG8_MMA
#undef PG8_WAIT_V
#undef PG8_WAIT_L
#undef PG8_BAR
#undef PG8_SCHED
}
}
constexpr int NWAVES = 8;
constexpr int BATCH = 4, SEQ = 8192, DM = 2048, DEPTH = 4;
constexpr int M = BATCH * SEQ;
constexpr int AW = 1024, NH = 16, HD = 64;
constexpr int SW = 1024, SG = 16, SP = 64, NG = 64;
constexpr int INW = 4096, FF = 8192, NMOD = 6 * DM;
constexpr float LN_EPS = 1e-5f;
constexpr float ALPHA = 1.681792830507429f;

constexpr size_t MiB = 1u << 20;
constexpr size_t WS_CTL = 0, CTL_ZERO_BYTES = 1 * MiB;
constexpr size_t WS_RF = 512 * 1024;
constexpr size_t WS_MODS = 1 * MiB;
constexpr size_t WS_STATS = 1 * MiB + 768 * 1024;
constexpr size_t WS_WIN = 2 * MiB;
constexpr size_t WS_WGLU = WS_WIN + 64 * MiB;
constexpr size_t WS_WOUT = WS_WGLU + 8 * MiB;
constexpr size_t WS_W1 = WS_WOUT + 32 * MiB;
constexpr size_t WS_W2 = WS_W1 + 128 * MiB;
constexpr size_t WS_H = WS_W2 + 128 * MiB;
constexpr size_t WS_YB = WS_H + 128 * MiB;
constexpr size_t WS_MRG = WS_YB + 128 * MiB;
constexpr size_t WS_BIG = WS_MRG + 128 * MiB;
constexpr size_t WS_QKV = WS_BIG, WS_UX = WS_BIG + 192 * MiB, WS_S = WS_BIG + 288 * MiB, WS_YACT = WS_BIG + 352 * MiB  , WS_HID = WS_BIG;
constexpr size_t WS_BST = WS_BIG + 512 * MiB;
constexpr size_t WS_WY = WS_BST + 64 * MiB;
constexpr size_t WS_SSQP = WS_WY + 192 * MiB;
constexpr size_t WS_END = WS_SSQP + 4 * MiB;
constexpr size_t WS_LNCNT = 768 * 1024, WS_LNQ = 768 * 1024 + 8192;
constexpr int CW_BAR = 4096;

constexpr int RING_OFF = 0, RING_BYTES = 131072;
constexpr int LDS_BYTES = 163840;
constexpr int LDSCTL_OFF = LDS_BYTES - 1024, MISC_OFF = LDSCTL_OFF + 320;

#define LAS __attribute__((address_space(3)))
typedef unsigned short bf16;
typedef unsigned v4u __attribute__((ext_vector_type(4)));
typedef float f32x4 __attribute__((ext_vector_type(4)));
typedef short bf16x8 __attribute__((ext_vector_type(8)));
typedef GAS unsigned gu32;
typedef GAS unsigned long long gu64;
#define RLX_AGENT __ATOMIC_RELAXED, __HIP_MEMORY_SCOPE_AGENT
#define LDS_WAIT() asm volatile("s_waitcnt lgkmcnt(0)" ::: "memory")
__device__ __forceinline__ unsigned f2bf(float f) { unsigned u = __builtin_bit_cast(unsigned, f); return (u + 0x7fffu + ((u >> 16) & 1u)) >> 16; }
__device__ __forceinline__ unsigned pk2(float lo, float hi) { return f2bf(lo) | (f2bf(hi) << 16); }

#define XB_TMO      128
#define XB_XCNT(j)  (256  + 64 * (j))
#define XB_XSUB(j)  (1280 + 64 * (j))
#define XB_XGEN(j)  (2304 + 64 * (j))
#define XB_TOP      3328
#define XB_TOPGEN   3392
#define XCD_BAR_WORDS 3456
#define XB_SPIN_CAP (1u << 18)

__device__ __forceinline__ unsigned xb_ld(unsigned* p)              { return __hip_atomic_load(p, __ATOMIC_RELAXED, __HIP_MEMORY_SCOPE_AGENT); }
__device__ __forceinline__ unsigned xb_add(unsigned* p, unsigned v) { return __hip_atomic_fetch_add(p, v, __ATOMIC_RELAXED, __HIP_MEMORY_SCOPE_AGENT); }
__device__ __forceinline__ unsigned xb_xcc_id() { return (unsigned)__builtin_amdgcn_s_getreg((3 << 11) | 20) & 0xFu; }
#define XB_SPIN(cond, bar) do { unsigned _sp = 0; while (cond) { __builtin_amdgcn_s_sleep(1); \
    if ((++_sp & 255u) == 0u) { if (xb_ld(&(bar)[XB_TMO])) break; if (_sp > XB_SPIN_CAP) { atomicAdd(&(bar)[XB_TMO], 1u); break; } } } } while (0)

struct XcdBarrier {
    unsigned* bar; unsigned x;
    volatile LAS unsigned* st;
};

__device__ __forceinline__ XcdBarrier xcd_barrier_post(unsigned* bar, volatile LAS unsigned* st) {
    XcdBarrier b; b.bar = bar; b.x = xb_xcc_id(); b.st = st;
    if (threadIdx.x == 0) (void)xb_add(&bar[XB_XCNT(b.x)], 1u);
    return b;
}
__device__ __forceinline__ void xcd_barrier_complete(unsigned* bar, unsigned x, unsigned& nloc, unsigned& nx) {
    const unsigned G = gridDim.x * gridDim.y * gridDim.z;
    unsigned sum, cnt, mine, sp = 0u;
    for (;;) {
        sum = 0u; cnt = 0u; mine = 0u;
#pragma unroll
        for (unsigned j = 0; j < 16; ++j) { const unsigned c = xb_ld(&bar[XB_XCNT(j)]); sum += c; cnt += (c > 0u) ? 1u : 0u; mine = (j == x) ? c : mine; }
        if (sum == G) break;
        __builtin_amdgcn_s_sleep(1);
        if ((++sp & 255u) == 0u) { if (xb_ld(&bar[XB_TMO])) break; if (sp > XB_SPIN_CAP) { atomicAdd(&bar[XB_TMO], 1u); break; } }
    }
    nloc = mine > 0u ? mine : 1u; nx = cnt > 0u ? cnt : 1u;
}

__device__ __forceinline__ void xcd_barrier(const XcdBarrier& b) {
    asm volatile("s_waitcnt vmcnt(0)" ::: "memory");
    __syncthreads();
    if (threadIdx.x == 0) {
        unsigned* bar = b.bar;
        __builtin_amdgcn_s_waitcnt(0);
        unsigned nloc = b.st[0], nx = b.st[1];
        if (nloc == 0u) { xcd_barrier_complete(bar, b.x, nloc, nx); b.st[0] = nloc; b.st[1] = nx; }
        const unsigned old = xb_add(&bar[XB_XSUB(b.x)], 1u);
        const unsigned gen = old / nloc;
        if (old + 1u == (gen + 1u) * nloc) {
            __builtin_amdgcn_fence(__ATOMIC_RELEASE, "agent");
            asm volatile("s_waitcnt vmcnt(0)" ::: "memory");
            const unsigned og = xb_add(&bar[XB_TOP], 1u);
            const unsigned tg = og / nx;
            if (og + 1u == (tg + 1u) * nx) xb_add(&bar[XB_TOPGEN], 1u);
            else XB_SPIN(xb_ld(&bar[XB_TOPGEN]) == tg, bar);
            __builtin_amdgcn_fence(__ATOMIC_ACQUIRE, "agent");
            xb_add(&bar[XB_XGEN(b.x)], 1u);
            asm volatile("s_waitcnt vmcnt(0)" ::: "memory");
        } else {
            XB_SPIN(xb_ld(&bar[XB_XGEN(b.x)]) == gen, bar);
            __builtin_amdgcn_fence(__ATOMIC_ACQUIRE, "agent");
            asm volatile("s_waitcnt vmcnt(0)" ::: "memory");
        }
    }
    __syncthreads();
}
__device__ __forceinline__ int opaque_tid() { int t = threadIdx.x; asm volatile("" : "+v"(t)); return t; }
__device__ __forceinline__ float wave_sum(float v) {
#pragma unroll
    for (int o = 1; o < 64; o <<= 1) v += __shfl_xor(v, o);
    return v;
}
template <int CTRL> __device__ __forceinline__ float dpp_mov_(float v) { return __uint_as_float((unsigned)__builtin_amdgcn_update_dpp(0, (int)__float_as_uint(v), CTRL, 0xF, 0xF, true)); }
__device__ __forceinline__ float wave_sum_fast(float v) {
    v += dpp_mov_<0xB1>(v); v += dpp_mov_<0x4E>(v); v += dpp_mov_<0x141>(v); v += dpp_mov_<0x140>(v);
    { auto r = __builtin_amdgcn_permlane16_swap(__float_as_uint(v), __float_as_uint(v), false, false); v = __uint_as_float(r[0]) + __uint_as_float(r[1]); }
    { auto r = __builtin_amdgcn_permlane32_swap(__float_as_uint(v), __float_as_uint(v), false, false); v = __uint_as_float(r[0]) + __uint_as_float(r[1]); }
    return v;
}
__device__ __forceinline__ void p0_transpose_item(const float* W, int K, int N, bf16* WT, LAS float* scr, int item, int lane, const float* ga = nullptr, const float* gs = nullptr) {
    const int nblk = N / 32, kb = item / nblk, nb = item % nblk, k0 = 64 * kb, n0 = 32 * nb;
    float wv[32];
#pragma unroll
    for (int i = 0; i < 32; ++i) wv[i] = W[(size_t)(k0 + 2 * i + (lane >> 5)) * N + n0 + (lane & 31)];
#pragma unroll
    for (int i = 0; i < 32; ++i) { const int k = k0 + 2 * i + (lane >> 5); const float gk = ga ? (k < 1024 ? ga[k] : gs[k - 1024]) : 1.f; scr[(2 * i + (lane >> 5)) * 33 + (lane & 31)] = wv[i] * gk; }
    LDS_WAIT(); asm volatile("" ::: "memory");
    const int c = lane & 7;
#pragma unroll
    for (int j = 0; j < 4; ++j) { const int n = (lane >> 3) + 8 * j; const LAS float* s = scr + (8 * c) * 33 + n;
        v4u o; o.x = pk2(s[0 * 33], s[1 * 33]); o.y = pk2(s[2 * 33], s[3 * 33]); o.z = pk2(s[4 * 33], s[5 * 33]); o.w = pk2(s[6 * 33], s[7 * 33]);
        *(GAS v4u*)(WT + (size_t)(n0 + n) * K + k0 + 8 * c) = o; }
    LDS_WAIT(); asm volatile("" ::: "memory");
}
struct Ptrs {
    const float* in[24]; float* out; unsigned char* ws;
};

__device__ __forceinline__ void p0_weights(LAS unsigned char* lds, int gw, int ngw, int wave) {
    const int lane = opaque_tid() & 63;
    LAS float* scr = (LAS float*)(lds + RING_OFF + wave * 16384);
    constexpr int I_IN = (DM / 64) * (INW / 32), I_GLU = (SW / 64) * (SW / 32), I_OUT = (DM / 64) * (DM / 32), I_1 = (DM / 64) * (FF / 32), I_2 = (FF / 64) * (DM / 32);
    constexpr int PER_LAYER = I_IN + I_GLU + I_OUT + I_1 + I_2;
    for (int it = gw; it < DEPTH * PER_LAYER; it += ngw) {
        const int l = it / PER_LAYER; int r = it % PER_LAYER;
        if (r < I_IN) { p0_transpose_item(IN(4) + (size_t)l * DM * INW, DM, INW, (bf16*)(WSP() + WS_WIN) + (size_t)l * INW * DM, scr, r, lane); continue; } r -= I_IN;
        if (r < I_GLU) { p0_transpose_item(IN(13) + (size_t)l * SW * SW, SW, SW, (bf16*)(WSP() + WS_WGLU) + (size_t)l * SW * SW, scr, r, lane); continue; } r -= I_GLU;
        if (r < I_OUT) { p0_transpose_item(IN(17) + (size_t)l * DM * DM, DM, DM, (bf16*)(WSP() + WS_WOUT) + (size_t)l * DM * DM, scr, r, lane, IN(15) + (size_t)l * AW, IN(16) + (size_t)l * SW); continue; } r -= I_OUT;
        if (r < I_1) { p0_transpose_item(IN(20) + (size_t)l * DM * FF, DM, FF, (bf16*)(WSP() + WS_W1) + (size_t)l * FF * DM, scr, r, lane); continue; } r -= I_1;
        p0_transpose_item(IN(21) + (size_t)l * FF * DM, FF, DM, (bf16*)(WSP() + WS_W2) + (size_t)l * DM * FF, scr, r, lane);
    }
}
__device__ __forceinline__ void p0_mods(LAS unsigned char* lds, int wave) {
    const int tid = opaque_tid(), lane = tid & 63;
    LAS float* cond = (LAS float*)(lds);
    LAS float* part = (LAS float*)(lds + 32768);
    const float* c = IN(1);
    for (int i = tid; i < BATCH * DM; i += NWAVES * 64) { const float v = c[i]; cond[i] = v / (1.f + __expf(-v)); }
    __syncthreads();
    float* mods = (float*)(WSP() + WS_MODS);
    constexpr int NCH = NMOD / 128;
    for (int it = blockIdx.x; it < DEPTH * NCH; it += gridDim.x) {
        const int l = it / NCH, n0 = (it % NCH) * 128;
        const float* W = IN(2) + (size_t)l * DM * NMOD + n0 + 4 * (lane & 31);
        const int kbase = wave * 256 + (lane >> 5);
        f32x4 a0 = {0.f, 0.f, 0.f, 0.f}, a1 = a0, a2 = a0, a3 = a0;
#pragma unroll 8
        for (int i = 0; i < 128; ++i) { const int k = kbase + 2 * i; const f32x4 w = *(const f32x4*)(W + (size_t)k * NMOD);
            a0 += w * cond[k]; a1 += w * cond[DM + k]; a2 += w * cond[2 * DM + k]; a3 += w * cond[3 * DM + k]; }
        const int slot = wave * 2 + (lane >> 5), cc = 4 * (lane & 31);
        *(LAS f32x4*)(part + (slot * 4 + 0) * 128 + cc) = a0; *(LAS f32x4*)(part + (slot * 4 + 1) * 128 + cc) = a1;
        *(LAS f32x4*)(part + (slot * 4 + 2) * 128 + cc) = a2; *(LAS f32x4*)(part + (slot * 4 + 3) * 128 + cc) = a3;
        __syncthreads();
        { const int b = tid >> 7, col = tid & 127; float s = 0.f;
#pragma unroll
          for (int sl = 0; sl < 16; ++sl) s += part[(sl * 4 + b) * 128 + col];
          mods[((size_t)l * BATCH + b) * NMOD + n0 + col] = s + IN(3)[(size_t)l * NMOD + n0 + col]; }
        __syncthreads();
    }
}
__device__ __forceinline__ void row_mod_pass(const float* X, bf16* H, bf16* YB, const float* mods_l  , int sh_off, int sc_off, int gw, int ngw) {
    const int lane = opaque_tid() & 63;
    for (int r = gw; r < M; r += ngw) {
        const int b = r / SEQ; const float* mb = mods_l + (size_t)b * NMOD;
        const float* xr = X + (size_t)r * DM; bf16* hr = H + (size_t)r * DM; bf16* yr = YB + (size_t)r * DM;
#pragma unroll
        for (int j = 0; j < 8; ++j) { const int col = 4 * (64 * j + lane);
            const f32x4 v = *(const f32x4*)(xr + col), sc = *(const f32x4*)(mb + sc_off + col), sh = *(const f32x4*)(mb + sh_off + col);
            const f32x4 h = v * (sc + 1.0f) + sh;
            uint2 o; o.x = pk2(h[0], h[1]); o.y = pk2(h[2], h[3]); *(uint2*)(hr + col) = o;
            { typedef _Float16 f16x4 __attribute__((ext_vector_type(4))); const f16x4 y = {(_Float16)v[0], (_Float16)v[1], (_Float16)v[2], (_Float16)v[3]}; *(uint2*)(yr + col) = __builtin_bit_cast(uint2, y); } }
    }
}
__device__ __forceinline__ void ln_row_math(int r, int lane, const v4u (&w)[4], bf16* H, float* XO, float* stats, const float* lg, const float* lb, const float* mods_l, int sh_off, int sc_off) {
    float v[4][8]; float s = 0.f;
#pragma unroll
    for (int j = 0; j < 4; ++j) {
        { f32x4 a_, b_; pg8::unpack_f16x8(w[j], a_, b_); v[j][0] = a_[0]; v[j][1] = a_[1]; v[j][2] = a_[2]; v[j][3] = a_[3]; v[j][4] = b_[0]; v[j][5] = b_[1]; v[j][6] = b_[2]; v[j][7] = b_[3]; }
#pragma unroll
        for (int e = 0; e < 8; ++e) s += v[j][e]; }
    const float mean = wave_sum_fast(s) * (1.f / DM); float s2 = 0.f;
#pragma unroll
    for (int j = 0; j < 4; ++j)
#pragma unroll
        for (int e = 0; e < 8; ++e) { v[j][e] -= mean; s2 += v[j][e] * v[j][e]; }
    const float rstd = 1.f / sqrtf(wave_sum_fast(s2) * (1.f / DM) + LN_EPS);
    if (lane == 0) { *(float2*)(stats + 2 * (size_t)r) = make_float2(mean, rstd); }
    const int b = r / SEQ; const float* mb = mods_l ? mods_l + (size_t)b * NMOD : nullptr; bf16* hr = H + (size_t)r * DM;
#pragma unroll
    for (int j = 0; j < 4; ++j) { const int col = 8 * (64 * j + lane);
        f32x4 x[2];
#pragma unroll
        for (int q = 0; q < 2; ++q) { const f32x4 vv = {v[j][4 * q], v[j][4 * q + 1], v[j][4 * q + 2], v[j][4 * q + 3]}; x[q] = vv * rstd * *(const f32x4*)(lg + col + 4 * q) + *(const f32x4*)(lb + col + 4 * q); }
        if (XO) { *(f32x4*)(XO + (size_t)r * DM + col) = x[0]; *(f32x4*)(XO + (size_t)r * DM + col + 4) = x[1]; }
        if (mb) { f32x4 h[2];
#pragma unroll
            for (int q = 0; q < 2; ++q) h[q] = x[q] * (*(const f32x4*)(mb + sc_off + col + 4 * q) + 1.0f) + *(const f32x4*)(mb + sh_off + col + 4 * q);
            v4u o; o.x = pk2(h[0][0], h[0][1]); o.y = pk2(h[0][2], h[0][3]); o.z = pk2(h[1][0], h[1][1]); o.w = pk2(h[1][2], h[1][3]); *(v4u*)(hr + col) = o; } }
}
__device__ __forceinline__ void ln_rows4_sc1(const bf16* YB, bf16* H, float* XO, float* stats, const float* lg, const float* lb, const float* mods_l, int sh_off, int sc_off, int r0) {
    const int lane = opaque_tid() & 63;
    v4u w[4][4];
#pragma unroll
    for (int k = 0; k < 4; ++k)
#pragma unroll
        for (int j = 0; j < 4; ++j) { const bf16* p = YB + (size_t)(r0 + k) * DM + 8 * (64 * j + lane); asm volatile("global_load_dwordx4 %0, %1, off sc1" : "=&v"(w[k][j]) : "v"(p) : "memory"); }
    asm volatile("s_waitcnt vmcnt(0)" : "+v"(w[0][0]), "+v"(w[0][1]), "+v"(w[0][2]), "+v"(w[0][3]), "+v"(w[1][0]), "+v"(w[1][1]), "+v"(w[1][2]), "+v"(w[1][3]),
                                         "+v"(w[2][0]), "+v"(w[2][1]), "+v"(w[2][2]), "+v"(w[2][3]), "+v"(w[3][0]), "+v"(w[3][1]), "+v"(w[3][2]), "+v"(w[3][3]) :: "memory");
#pragma unroll
    for (int k = 0; k < 4; ++k) ln_row_math(r0 + k, lane, w[k], H, XO, stats, lg, lb, mods_l, sh_off, sc_off);
}
__device__ __forceinline__ void ln_queue_pass(LAS unsigned char* lds, int inst, const bf16* YB, bf16* H, float* XO, float* stats, const float* lg, const float* lb, const float* mods_l, int sh_off, int sc_off, int G) {
    typedef GAS unsigned gu32_;
    gu32_* q = (gu32_*)(WSP() + WS_LNQ) + inst * 64; gu32_* cnt = (gu32_*)(WSP() + WS_LNCNT) + inst * 128;
    volatile LAS unsigned* bc = (volatile LAS unsigned*)(lds + LDSCTL_OFF + 1008);
    const int tid = opaque_tid(), wave = tid >> 6;
    for (unsigned it = 0;; ++it) {
        if (tid == 0) { const unsigned hp = __hip_atomic_fetch_add(q, 1u, __ATOMIC_RELAXED, __HIP_MEMORY_SCOPE_AGENT);
            if (hp < 1024u) { const unsigned n = hp >> 3; unsigned panel = n;
                if (G == 256) { const unsigned i = n >> 5, rem = n & 31u; panel = 4u * ((rem >> 2) * 4u + i) + (rem & 3u); }
                for (unsigned spins = 0; __hip_atomic_load(cnt + panel, __ATOMIC_RELAXED, __HIP_MEMORY_SCOPE_AGENT) != 8u && spins < (1u << 24); ++spins) __builtin_amdgcn_s_sleep(4);
                bc[it & 1u] = panel * 256u + (hp & 7u) * 32u; }
            else bc[it & 1u] = 0xFFFFFFFFu; }
        __syncthreads();
        const unsigned rb = bc[it & 1u];
        if (rb == 0xFFFFFFFFu) break;
        ln_rows4_sc1(YB, H, XO, stats, lg, lb, mods_l, sh_off, sc_off, (int)rb + wave * 4);
    }
}
__device__ __forceinline__ void row_factor_pass(const float* SSQP  , float* RF  , int gtid0, int ngt) {
    const int gtid = gtid0 + opaque_tid();
    for (int r = gtid; r < M; r += ngt) {
        float sa = 0.f, ss = 0.f;
#pragma unroll
        for (int j = 0; j < 4; ++j) { const f32x4 a = *(const f32x4*)(SSQP + (size_t)r * 16 + 4 * j), s = *(const f32x4*)(SSQP + ((size_t)M + r) * 16 + 4 * j);
            sa += (a[0] + a[1]) + (a[2] + a[3]); ss += (s[0] + s[1]) + (s[2] + s[3]); }
        const float va = sa * (1.f / AW) + LN_EPS, vs = ss * (1.f / SW) + LN_EPS;
        *(float2*)(RF + 2 * (size_t)r) = make_float2(sqrtf(vs / va), 1.0f / sqrtf(vs));
    }
}
namespace at3 {
typedef short bf16x8 __attribute__((ext_vector_type(8)));
typedef short s16x4 __attribute__((ext_vector_type(4)));
typedef short v4i16_t __attribute__((ext_vector_type(4)));
typedef float f32x4 __attribute__((ext_vector_type(4)));
typedef float f32x2_t __attribute__((ext_vector_type(2))); typedef __bf16 bf16x2_t __attribute__((ext_vector_type(2)));
__device__ __forceinline__ unsigned cvtpk(float lo, float hi) { f32x2_t v = {lo, hi}; bf16x2_t b = __builtin_convertvector(v, bf16x2_t); return __builtin_bit_cast(unsigned, b); }
#define AT_LAS __attribute__((address_space(3)))
#define WG_BAR() asm volatile("s_waitcnt lgkmcnt(0)\n\ts_barrier" ::: "memory")
constexpr int NSTG = 27, NS1 = 5, NS2 = 11, NSLOT2 = 21;
constexpr int KROW = 144, KIMG = 32 * KROW, SUBI = 1056, VIMG = 4 * SUBI, WIMG = KIMG + VIMG;
constexpr int OLW = 68;
constexpr int LDS_OL = 8 * WIMG, LDS_ML = LDS_OL + 256 * OLW * 4, LDS_LL = LDS_ML + 1024, LDS_ATT_END = LDS_LL + 1024;
constexpr float QSCALE = 0.125f * 1.4426950408889634f;
constexpr float THR = 8.f;
__host__ __device__ constexpr int p2_pi(int t) { return t < 9 ? 0 : 1; }
__host__ __device__ constexpr int pi_d(int pi) { return pi == 0 ? 16 : (pi == 1 ? 4 : 1); }
__host__ __device__ constexpr int p2_mt(int t) { return t < 9 ? 16 * t : 16 * (t - 9); }
struct UnitCtx { const char* Kb; const char* Vb; const char* Qb; char* Ob; float* Sq; int T0; };
struct LaneK { unsigned voffR[3]; float jfb0[3]; int lane; };
__device__ __forceinline__ float lane_max16(float x) { auto r = __builtin_amdgcn_permlane16_swap(__float_as_uint(x), __float_as_uint(x), false, false); return fmaxf(__uint_as_float(r[0]), __uint_as_float(r[1])); }
__device__ __forceinline__ float lane_max32(float x) { auto r = __builtin_amdgcn_permlane32_swap(__float_as_uint(x), __float_as_uint(x), false, false); return fmaxf(__uint_as_float(r[0]), __uint_as_float(r[1])); }
template <int S> struct StageInfo {
    static constexpr bool P1 = S < NS1;
    static constexpr int ls = P1 ? S : (S - NS1) % NS2;
    static constexpr int setB = P1 ? 0 : (S - NS1) / NS2;
    static constexpr int slot(int hh) { return 2 * ls + hh; }
};
template <int S> __device__ __forceinline__ void issue_stage(const UnitCtx& c, int wave, const LaneK& L, v4u (&kf)[4], v4u (&vf)[4]) {
    typedef StageInfo<S> SI;
#pragma unroll
    for (int cc = 0; cc < 4; ++cc) {
        long tok; int pi;
        if constexpr (SI::P1) { pi = 2; tok = c.T0 + 32 * wave - 64 + 32 * SI::ls + 8 * cc; }
        else { const int t = (SI::slot(cc >> 1) < NSLOT2) ? SI::slot(cc >> 1) : SI::slot(0); pi = p2_pi(t); const int d = pi_d(pi);
               tok = c.T0 + 2 * wave + SI::setB - 64 * d + d * (p2_mt(t) + 8 * (cc & 1)); }
        const long off = tok * (HD * 2);
        kf[cc] = *(const v4u*)(c.Kb + off + L.voffR[pi]); vf[cc] = *(const v4u*)(c.Vb + off + L.voffR[pi]); }
}
__device__ __forceinline__ void write_images(AT_LAS unsigned char* img, int lane, const v4u (&kf)[4], const v4u (&vf)[4]) {
    AT_LAS unsigned char* kp = img + (lane >> 3) * KROW + (lane & 7) * 16;
    AT_LAS unsigned char* vp = img + KIMG + ((lane & 7) >> 1) * SUBI + (lane >> 3) * 32 + (lane & 1) * 16;
#pragma unroll
    for (int cc = 0; cc < 4; ++cc) { *(AT_LAS v4u*)(kp + cc * 8 * KROW) = kf[cc]; *(AT_LAS v4u*)(vp + cc * 256) = vf[cc]; }
}
__device__ __forceinline__ void read_kfrag(const AT_LAS unsigned char* img, int lane, bf16x8 (&ka)[4]) {
    const AT_LAS unsigned char* p = img + (lane & 15) * KROW + (lane >> 4) * 16;
#pragma unroll
    for (int hh = 0; hh < 2; ++hh) { ka[2 * hh] = *(const AT_LAS bf16x8*)(p + hh * 16 * KROW); ka[2 * hh + 1] = *(const AT_LAS bf16x8*)(p + hh * 16 * KROW + 64); }
}
__device__ __forceinline__ void read_vfrag(const AT_LAS unsigned char* img, int lane, bf16x8 (&va)[4]) {
    const AT_LAS unsigned char* vb = img + KIMG + (4 * (lane >> 4) + ((lane & 15) >> 2)) * 32 + 8 * (lane & 3);
#pragma unroll
    for (int cc = 0; cc < 4; ++cc) {
        const s16x4 lo = __builtin_bit_cast(s16x4, __builtin_amdgcn_ds_read_tr16_b64_v4i16((AT_LAS v4i16_t*)(vb + cc * SUBI)));
        const s16x4 hi = __builtin_bit_cast(s16x4, __builtin_amdgcn_ds_read_tr16_b64_v4i16((AT_LAS v4i16_t*)(vb + cc * SUBI + 512)));
        va[cc] = (bf16x8){lo[0], lo[1], lo[2], lo[3], hi[0], hi[1], hi[2], hi[3]}; }
}
__device__ __forceinline__ bf16x8 softmax_step(const bf16x8 (&ka)[4], const bf16x8 (&qf)[2], const float (&jf0)[2], const float (&jc)[2], const bool (&have)[2], const float (&bsv)[2],
                                               const float (&jlo)[2], const float (&jhi)[2], f32x4 (&oacc)[4], float& m_run, float& l_run) {
    const f32x4 z = {0.f, 0.f, 0.f, 0.f};
    float s[8];
#pragma unroll
    for (int hh = 0; hh < 2; ++hh) {
        if (have[hh]) {
            f32x4 st = __builtin_amdgcn_mfma_f32_16x16x32_bf16(ka[2 * hh], qf[0], z, 0, 0, 0); st = __builtin_amdgcn_mfma_f32_16x16x32_bf16(ka[2 * hh + 1], qf[1], st, 0, 0, 0);
#pragma unroll
            for (int e = 0; e < 4; ++e) { const float jf = jf0[hh] + (jc[hh] + (float)e); const bool valid = (jf >= jlo[hh]) && (jf <= jhi[hh]);
                s[4 * hh + e] = valid ? __builtin_fmaf(-bsv[hh], __builtin_fabsf(jf), st[e]) : -__builtin_inff(); }
        } else {
#pragma unroll
            for (int e = 0; e < 4; ++e) s[4 * hh + e] = -__builtin_inff(); } }
    float mx = fmaxf(fmaxf(fmaxf(s[0], s[1]), fmaxf(s[2], s[3])), fmaxf(fmaxf(s[4], s[5]), fmaxf(s[6], s[7])));
    mx = lane_max16(mx); mx = lane_max32(mx);
    if (__any(mx > m_run + THR)) {
        const float mn = fmaxf(m_run, mx), alpha = __builtin_amdgcn_exp2f(m_run - mn); m_run = mn; l_run *= alpha;
#pragma unroll
        for (int cc = 0; cc < 4; ++cc) oacc[cc] = oacc[cc] * alpha; }
    float p[8]; float ps = 0.f;
#pragma unroll
    for (int k = 0; k < 8; ++k) { p[k] = __builtin_amdgcn_exp2f(s[k] - m_run); ps += p[k]; }
    l_run += ps;
    unsigned pw[4] = {cvtpk(p[0], p[1]), cvtpk(p[2], p[3]), cvtpk(p[4], p[5]), cvtpk(p[6], p[7])};
    return __builtin_bit_cast(bf16x8, *(const v4u*)pw);
}
struct WaveState {
    bf16x8 q1[2][2], q2[2], qn[2];
    f32x4 o1[2][4], o2[4]; float m1[2], l1[2], m2, l2;
    float jlo1[2], jhi1[2], jlo2[2], jhi2[2];
};
__device__ __forceinline__ void load_q(const char* Qb, long tok0, int stride, int lane_, bf16x8 (&qf)[2]) {
    const int lane = opaque_tid() & 63; (void)lane_;
    const char* qp = Qb + ((tok0 + (long)stride * (lane & 15)) * AW + 8 * (lane >> 4)) * 2; qf[0] = *(const bf16x8*)qp; qf[1] = *(const bf16x8*)(qp + 64); }
template <int S> __device__ __forceinline__ void compute_stage(const UnitCtx& c, int wave, const LaneK& L, const float (&bs)[3], AT_LAS unsigned char* lds, AT_LAS unsigned char* img,
                                                               const v4u (&kf)[4], const v4u (&vf)[4], WaveState& W) {
    typedef StageInfo<S> SI;
    const int lane = L.lane, n = lane & 15, g = lane >> 4;
    write_images(img, lane, kf, vf);
    bf16x8 ka[4], va[4];
    read_kfrag(img, lane, ka);
    if constexpr (SI::P1) {
        bf16x8 pb[2];
#pragma unroll
        for (int s2 = 0; s2 < 2; ++s2) {
            const float jf0[2] = {L.jfb0[2], L.jfb0[2]}, jc[2] = {(float)(32 * SI::ls - 16 * s2), (float)(32 * SI::ls + 16 - 16 * s2)}; const bool have[2] = {true, true};
            const float bsv[2] = {bs[2], bs[2]}, jlo[2] = {W.jlo1[s2], W.jlo1[s2]}, jhi[2] = {W.jhi1[s2], W.jhi1[s2]};
            pb[s2] = softmax_step(ka, W.q1[s2], jf0, jc, have, bsv, jlo, jhi, W.o1[s2], W.m1[s2], W.l1[s2]); }
        read_vfrag(img, lane, va);
#pragma unroll
        for (int s2 = 0; s2 < 2; ++s2)
#pragma unroll
            for (int cc = 0; cc < 4; ++cc) W.o1[s2][cc] = __builtin_amdgcn_mfma_f32_16x16x32_bf16(va[cc], pb[s2], W.o1[s2][cc], 0, 0, 0);
    } else {
        constexpr int t0 = SI::slot(0), t1 = SI::slot(1); constexpr bool h1 = t1 < NSLOT2; constexpr int t1c = h1 ? t1 : t0;
        constexpr int p0 = p2_pi(t0), p1 = p2_pi(t1c);
        const float jf0[2] = {L.jfb0[p0], L.jfb0[p1]}, jc[2] = {(float)p2_mt(t0), (float)p2_mt(t1c)}; const bool have[2] = {true, h1};
        const float bsv[2] = {bs[p0], bs[p1]}, jlo[2] = {W.jlo2[p0], W.jlo2[p1]}, jhi[2] = {W.jhi2[p0], W.jhi2[p1]};
        const bf16x8 pb = softmax_step(ka, W.q2, jf0, jc, have, bsv, jlo, jhi, W.o2, W.m2, W.l2);
        read_vfrag(img, lane, va);
#pragma unroll
        for (int cc = 0; cc < 4; ++cc) W.o2[cc] = __builtin_amdgcn_mfma_f32_16x16x32_bf16(va[cc], pb, W.o2[cc], 0, 0, 0);
    }
}
__device__ __forceinline__ void jwin(int tq, int sh, float& lo, float& hi) { const int a = -(tq >> sh), b = (SEQ - 1 - tq) >> sh; lo = (float)(a < -64 ? -64 : a); hi = (float)(b > 64 ? 64 : b); }
__device__ __forceinline__ void begin_pass1(const UnitCtx& c, int wave, const LaneK& L, WaveState& W) {
    const int n = opaque_tid() & 15;
#pragma unroll
    for (int s2 = 0; s2 < 2; ++s2) { W.m1[s2] = -1e30f; W.l1[s2] = 0.f; jwin(c.T0 + 32 * wave + 16 * s2 + n, 0, W.jlo1[s2], W.jhi1[s2]);
#pragma unroll
        for (int cc = 0; cc < 4; ++cc) W.o1[s2][cc] = (f32x4){0.f, 0.f, 0.f, 0.f}; }
}
__device__ __forceinline__ void end_pass1(int wave, const LaneK& L, AT_LAS unsigned char* lds, WaveState& W) {
    const int ln_ = opaque_tid() & 63, n = ln_ & 15, g = ln_ >> 4;
#pragma unroll
    for (int s2 = 0; s2 < 2; ++s2) { const int q = 32 * wave + 16 * s2 + n;
        float lt = W.l1[s2]; lt = fsum_x16x32(lt);
#pragma unroll
        for (int cc = 0; cc < 4; ++cc) *(AT_LAS f32x4*)(lds + LDS_OL + (q * OLW + 16 * cc + 4 * g) * 4) = W.o1[s2][cc];
        if (g == 0) { *(AT_LAS float*)(lds + LDS_ML + 4 * q) = W.m1[s2]; *(AT_LAS float*)(lds + LDS_LL + 4 * q) = lt; } }
}
__device__ __forceinline__ void begin_pass2(const UnitCtx& c, int r, const LaneK& L, AT_LAS unsigned char* lds, WaveState& W) {
    const int ln_ = opaque_tid() & 63, n = ln_ & 15, g = ln_ >> 4, q = r + 16 * n;
#pragma unroll
    for (int cc = 0; cc < 4; ++cc) W.o2[cc] = *(const AT_LAS f32x4*)(lds + LDS_OL + (q * OLW + 16 * cc + 4 * g) * 4);
    W.m2 = *(const AT_LAS float*)(lds + LDS_ML + 4 * q); const float lq = *(const AT_LAS float*)(lds + LDS_LL + 4 * q); W.l2 = (g == 0) ? lq : 0.f;
    jwin(c.T0 + q, 4, W.jlo2[0], W.jhi2[0]); jwin(c.T0 + q, 2, W.jlo2[1], W.jhi2[1]);
}
__device__ __forceinline__ void end_pass2(const UnitCtx& c, int r, const LaneK& L, WaveState& W) {
    const int ln_ = opaque_tid() & 63, n = ln_ & 15, g = ln_ >> 4;
    float lt = W.l2; lt = fsum_x16x32(lt);
    const float inv = 1.f / lt;
    char* op = c.Ob + ((long)(c.T0 + r + 16 * n) * DM + 4 * g) * 2;
    float sq = 0.f;
#pragma unroll
    for (int cc = 0; cc < 4; ++cc) { const f32x4 o = W.o2[cc] * inv; sq += (o[0] * o[0] + o[1] * o[1]) + (o[2] * o[2] + o[3] * o[3]);
        uint2 w; w.x = cvtpk(o[0], o[1]); w.y = cvtpk(o[2], o[3]); *(uint2*)(op + 32 * cc) = w; }
    sq = fsum_x16x32(sq);
    if (g == 0) c.Sq[(size_t)(c.T0 + r + 16 * n) * 16] = sq;
}
template <int S> struct StageLoop {
    static __device__ __forceinline__ void run(const UnitCtx& cur, const UnitCtx& nxt, int wave, const LaneK& L, const float (&bs)[3], AT_LAS unsigned char* lds, AT_LAS unsigned char* img,
                                               v4u (&kf)[3][4], v4u (&vf)[3][4], WaveState& W) {
        constexpr int T = S + 2;
        if constexpr (T < NSTG) issue_stage<T>(cur, wave, L, kf[T % 3], vf[T % 3]);
        else issue_stage<T - NSTG>(nxt, wave, L, kf[T % 3], vf[T % 3]);
        if constexpr (S == NS1 - 3) load_q(cur.Qb, cur.T0 + 2 * wave, 16, L.lane, W.q2);
        if constexpr (S == NS1 + NS2 - 3) load_q(cur.Qb, cur.T0 + 2 * wave + 1, 16, L.lane, W.qn);
        if constexpr (S == NSTG - 3) { load_q(nxt.Qb, nxt.T0 + 32 * wave, 1, L.lane, W.q1[0]); load_q(nxt.Qb, nxt.T0 + 32 * wave + 16, 1, L.lane, W.q1[1]); }
        __builtin_amdgcn_sched_barrier(0);
        if constexpr (S == 0) begin_pass1(cur, wave, L, W);
        if constexpr (S == NS1) { end_pass1(wave, L, lds, W); WG_BAR(); begin_pass2(cur, 2 * wave, L, lds, W); }
        if constexpr (S == NS1 + NS2) { end_pass2(cur, 2 * wave, L, W); W.q2[0] = W.qn[0]; W.q2[1] = W.qn[1]; begin_pass2(cur, 2 * wave + 1, L, lds, W); WG_BAR(); }
        compute_stage<S>(cur, wave, L, bs, lds, img, kf[S % 3], vf[S % 3], W);
        if constexpr (S == NSTG - 1) end_pass2(cur, 2 * wave + 1, L, W);
        __builtin_amdgcn_sched_barrier(0);
        StageLoop<S + 1>::run(cur, nxt, wave, L, bs, lds, img, kf, vf, W);
    }
};
template <> struct StageLoop<NSTG> { static __device__ __forceinline__ void run(const UnitCtx&, const UnitCtx&, int, const LaneK&, const float (&)[3], AT_LAS unsigned char*, AT_LAS unsigned char*, v4u (&)[3][4], v4u (&)[3][4], WaveState&) {} };
__device__ __forceinline__ UnitCtx make_ctx(const bf16* Q, const bf16* K, const bf16* V, bf16* O, float* SSQ, int u) {
    const int sb = u & 31, h = (u >> 5) & 15, b = u >> 9; const size_t rb = (size_t)b * SEQ;
    UnitCtx c; c.Kb = (const char*)(K + ((size_t)h * M + rb) * HD); c.Vb = (const char*)(V + ((size_t)h * M + rb) * HD);
    c.Qb = (const char*)(Q + rb * AW + h * HD); c.Ob = (char*)(O + rb * DM + h * HD); c.Sq = SSQ + rb * 16 + h; c.T0 = sb * 256; return c;
}
__device__ __forceinline__ void attn_phase(const bf16* Q, const bf16* K, const bf16* V, bf16* O  , float* SSQ, AT_LAS unsigned char* lds, int vcu, int G, int wave) {
    LaneK L; L.lane = opaque_tid() & 63;
    const int lane = L.lane, n = lane & 15, g = lane >> 4;
#pragma unroll
    for (int pi = 0; pi < 3; ++pi) { const int d = pi_d(pi); L.voffR[pi] = (unsigned)(d * (lane >> 3) * HD + 8 * (lane & 7)) * 2u; L.jfb0[pi] = (float)(4 * g - 64 - (pi == 2 ? 1 : 16 / d) * n); }
    AT_LAS unsigned char* img = lds + wave * WIMG;
    const int NU = BATCH * NH * (SEQ / 256);
    if (vcu >= NU) return;
    UnitCtx cur = make_ctx(Q, K, V, O, SSQ, vcu);
    v4u kf[3][4], vf[3][4]; WaveState W;
    load_q(cur.Qb, cur.T0 + 32 * wave, 1, lane, W.q1[0]); load_q(cur.Qb, cur.T0 + 32 * wave + 16, 1, lane, W.q1[1]);
    issue_stage<0>(cur, wave, L, kf[0], vf[0]); issue_stage<1>(cur, wave, L, kf[1], vf[1]);
#pragma unroll 1
    for (int k = 0;; ++k) {
        asm volatile("" : "+v"(L.jfb0[0]), "+v"(L.jfb0[1]), "+v"(L.jfb0[2]));
        const int un = vcu + G * (k + 1); const bool has_next = un < NU;
        const UnitCtx nxt = has_next ? make_ctx(Q, K, V, O, SSQ, un) : cur;
        const int h = ((vcu + G * k) >> 5) & 15;
        const float slope2 = exp2f(-0.5f * (float)(h + 1)) * 1.4426950408889634f;
        const float bs[3] = {slope2 * 16.f, slope2 * 4.f, slope2};
        StageLoop<0>::run(cur, nxt, wave, L, bs, lds, img, kf, vf, W);
        if (!has_next) break;
        cur = nxt;
    }
}
}


constexpr int CH = 32, NCHUNK = M / CH  , CPS = SEQ / CH  , KX = 768;
constexpr int T_PW = 0;
constexpr int T_BB = 8192;
constexpr int T_CC = 12288;
constexpr int T_KT = 16384;
typedef float f32x2v __attribute__((ext_vector_type(2)));
__device__ __forceinline__ f32x2v cmul(f32x2v a, f32x2v b) { return (f32x2v){a.x * b.x - a.y * b.y, a.x * b.y + a.y * b.x}; }
__device__ __forceinline__ void ssm_prep_item(int l, int g, LAS unsigned char* lds, bf16* BST  , bf16* WY  ) {
    const int tid = opaque_tid();
    LAS float* T = (LAS float*)lds;
    LAS f32x2v* PW = (LAS f32x2v*)(T + T_PW); LAS f32x2v* BB = (LAS f32x2v*)(T + T_BB); LAS f32x2v* CC = (LAS f32x2v*)(T + T_CC); LAS float* KT = T + T_KT;
    {
#pragma unroll 1
        for (int k = 0; k < 4; ++k) { const int idx = tid + 512 * k; const int dir = idx >> 10, p = (idx >> 4) & 63, c = idx & 15;
            const size_t gi = ((size_t)l * 2 + dir) * NG + g;
            const float step = __expf(IN(7)[gi]); const float lr = IN(5)[gi * SP + p], li = IN(6)[gi * SP + p];
            const float mag = __expf(lr * step); float sn, cs; sincosf(li * step, &sn, &cs);
            const float a_re = mag * cs, a_im = mag * sn, den = lr * lr + li * li;
            const float cf_re = ((a_re - 1.f) * lr + a_im * li) / den, cf_im = (a_im * lr - (a_re - 1.f) * li) / den;
            const float br = IN(8)[(gi * SP + p) * SG + c], bi = IN(9)[(gi * SP + p) * SG + c];
            BB[(dir * 64 + p) * 16 + c] = (f32x2v){cf_re * br - cf_im * bi, cf_re * bi + cf_im * br};
            const int co = (idx >> 6) & 15, pp = idx & 63;
            CC[idx] = (f32x2v){IN(10)[(gi * SG + co) * SP + pp], IN(11)[(gi * SG + co) * SP + pp]}; }
        if (tid < 128) { const int dir = tid >> 6, p = tid & 63; const size_t gi = ((size_t)l * 2 + dir) * NG + g;
            const float step = __expf(IN(7)[gi]); const float lr = IN(5)[gi * SP + p], li = IN(6)[gi * SP + p];
#pragma unroll 1
            for (int e = 1; e <= 32; ++e) { const float mag = __expf(lr * step * (float)e); float sn, cs; sincosf(li * step * (float)e, &sn, &cs);
                PW[(dir * 32 + (e - 1)) * 64 + p] = (f32x2v){mag * cs, mag * sn}; } }
    }
    __syncthreads();
#define PWR_(dir, e, p) ((e) == 0 ? (f32x2v){1.f, 0.f} : PW[((dir) * 32 + ((e) > 0 ? (e) - 1 : 0)) * 64 + (p)])
    {   const int dir = tid >> 8, co = (tid >> 4) & 15, ci = tid & 15;
        float acc[32];
#pragma unroll
        for (int i = 0; i < 32; ++i) acc[i] = 0.f;
#pragma unroll 1
        for (int p = 0; p < 64; ++p) { const f32x2v w = cmul(CC[(dir * 16 + co) * 64 + p], BB[(dir * 64 + p) * 16 + ci]);
            acc[0] += w.x;
#pragma unroll
            for (int lag = 1; lag < 32; ++lag) { const f32x2v pw = PW[(dir * 32 + lag - 1) * 64 + p]; acc[lag] += w.x * pw.x - w.y * pw.y; } }
#pragma unroll
        for (int lag = 0; lag < 32; ++lag) KT[(dir * 32 + lag) * 256 + co * 16 + ci] = acc[lag];
    }
    __syncthreads();
    {   bf16* W = WY + (size_t)g * 512 * KX; const float* Dk = IN(12) + (size_t)l * SW + g * SG;
#pragma unroll 1
        for (int v = tid; v < 512 * 96; v += NWAVES * 64) { const int n = v / 96, kv = v % 96, i = n >> 4, co = n & 15, k0 = 8 * kv;
            float val[8];
            if (k0 < 512) { const int j = k0 >> 4, ci0 = k0 & 15;
                if (j < i) {
#pragma unroll
                    for (int e = 0; e < 8; ++e) val[e] = KT[(0 * 32 + (i - j)) * 256 + co * 16 + ci0 + e];
                } else if (j > i) {
#pragma unroll
                    for (int e = 0; e < 8; ++e) val[e] = KT[(1 * 32 + (j - i)) * 256 + co * 16 + ci0 + e];
                } else { const float dsk = Dk[co];
#pragma unroll
                    for (int e = 0; e < 8; ++e) val[e] = KT[co * 16 + ci0 + e] + KT[32 * 256 + co * 16 + ci0 + e] + ((ci0 + e == co) ? dsk : 0.f); }
            } else { const int q = k0 - 512, dir = q >> 7, comp = (q >> 6) & 1, p0 = q & 63; const int e_ = dir == 0 ? i + 1 : 32 - i;
#pragma unroll
                for (int e = 0; e < 8; ++e) { const f32x2v z = cmul(CC[(dir * 16 + co) * 64 + p0 + e], PW[(dir * 32 + e_ - 1) * 64 + p0 + e]); val[e] = comp == 0 ? z.x : -z.y; } }
            v4u o; o.x = pk2(val[0], val[1]); o.y = pk2(val[2], val[3]); o.z = pk2(val[4], val[5]); o.w = pk2(val[6], val[7]);
            *(v4u*)(W + (size_t)n * KX + k0) = o; }
    }
    {   bf16* B = BST + (size_t)g * 256 * 512;
#pragma unroll 1
        for (int v = tid; v < 256 * 64; v += NWAVES * 64) { const int n = v >> 6, kv = v & 63, dir = n >> 7, comp = (n >> 6) & 1, p = n & 63, j = kv >> 1, ci0 = (kv & 1) * 8;
            const int e_ = dir == 0 ? 31 - j : j; const f32x2v pw = PWR_(dir, e_, p);
            float val[8];
#pragma unroll
            for (int e = 0; e < 8; ++e) { const f32x2v z = cmul(pw, BB[(dir * 64 + p) * 16 + ci0 + e]); val[e] = comp == 0 ? z.x : z.y; }
            v4u o; o.x = pk2(val[0], val[1]); o.y = pk2(val[2], val[3]); o.z = pk2(val[4], val[5]); o.w = pk2(val[6], val[7]);
            *(v4u*)(B + (size_t)n * 512 + 8 * kv) = o; }
    }
#undef PWR_
    __syncthreads();
}
__device__ __forceinline__ void ssm_scan_coop(int l, const float* S  , bf16* UX  , LAS unsigned char* lds, int vcu, int G, int wave) {
    const int lane = opaque_tid() & 63;
    const int seg = wave & 3, slot = wave >> 2;
    LAS float* T = (LAS float*)lds;
    for (int it0 = vcu; it0 < NG * BATCH * 2; it0 += 2 * G) {
        const int it = it0 + slot * G; const bool act = it < NG * BATCH * 2;
        const int itc = act ? it : it0;
        const int dir = itc & 1, b = (itc >> 1) & 3, g = itc >> 3;
        const size_t gi = ((size_t)l * 2 + dir) * NG + g;
        const float step = __expf(IN(7)[gi]); const float lr = IN(5)[gi * SP + lane], li = IN(6)[gi * SP + lane];
        float sn, cs; const float mag = __expf(lr * step * (float)CH); sincosf(li * step * (float)CH, &sn, &cs);
        const float ar = mag * cs, ai = mag * sn;
        const float magS = __expf(lr * step * (float)(CH * 64)); float snS, csS; sincosf(li * step * (float)(CH * 64), &snS, &csS);
        const float Ar = magS * csS, Ai = magS * snS;
        const size_t row0 = (size_t)g * NCHUNK + (size_t)b * CPS;
        const float* Sp = S + row0 * 256 + dir * 128 + lane; bf16* Xp = UX + row0 * KX + 512 + dir * 128 + lane;
        float sr[64], si[64];
#pragma unroll
        for (int k = 0; k < 64; ++k) { const int cc = 64 * seg + k, c = dir ? (CPS - 1 - cc) : cc; sr[k] = Sp[(size_t)c * 256]; si[k] = Sp[(size_t)c * 256 + 64]; }
        float er = 0.f, ei = 0.f;
#pragma unroll
        for (int k = 0; k < 64; ++k) { const float nr = ar * er - ai * ei + sr[k], ni = ar * ei + ai * er + si[k]; er = nr; ei = ni; }
        T[((slot * 4 + seg) * 2 + 0) * 64 + lane] = er; T[((slot * 4 + seg) * 2 + 1) * 64 + lane] = ei;
        __syncthreads();
        er = 0.f; ei = 0.f;
        for (int q = 0; q < seg; ++q) { const float tr = T[((slot * 4 + q) * 2 + 0) * 64 + lane], ti = T[((slot * 4 + q) * 2 + 1) * 64 + lane];
            const float nr = Ar * er - Ai * ei + tr, ni = Ar * ei + Ai * er + ti; er = nr; ei = ni; }
        if (act) {
#pragma unroll
            for (int k = 0; k < 64; ++k) { const int cc = 64 * seg + k, c = dir ? (CPS - 1 - cc) : cc;
                Xp[(size_t)c * KX] = (bf16)f2bf(er); Xp[(size_t)c * KX + 64] = (bf16)f2bf(ei);
                const float nr = ar * er - ai * ei + sr[k], ni = ar * ei + ai * er + si[k]; er = nr; ei = ni; } }
        __syncthreads();
    }
}

__global__ void __launch_bounds__(NWAVES * 64, 2) mega_fwd(Ptrs P_unused) {
    extern __shared__ __attribute__((aligned(16))) unsigned char lds_raw[];
    LAS unsigned char* lds = (LAS unsigned char*)lds_raw;
    const int tid = threadIdx.x, wave = __builtin_amdgcn_readfirstlane(tid >> 6);
    const int G = gridDim.x;
    const int vcu = (G % 8 == 0) ? ((int)blockIdx.x % 8) * (G / 8) + (int)blockIdx.x / 8 : (int)blockIdx.x;
    const int gw = vcu * NWAVES + wave, ngw = G * NWAVES;
    for (int u = tid; u < (LDS_BYTES - LDSCTL_OFF) / 4; u += NWAVES * 64) ((LAS unsigned*)(lds + LDSCTL_OFF))[u] = 0u;
    __syncthreads();
    (void)xcd_barrier_post(WSB(unsigned, WS_CTL) + CW_BAR, (volatile LAS unsigned*)(lds + MISC_OFF) + 8);
#define GRID_BAR() do { XcdBarrier b_; b_.bar = WSB(unsigned, WS_CTL) + CW_BAR; b_.x = xb_xcc_id(); b_.st = (volatile LAS unsigned*)(lds + MISC_OFF) + 8; xcd_barrier(b_); } while (0)

    p0_mods(lds, wave);
    __syncthreads();
    p0_weights(lds, gw, ngw, wave);
    __syncthreads();
    for (int it = vcu; it < DEPTH * NG; it += G) ssm_prep_item(it / NG, it % NG, lds, WSB(bf16, WS_BST) + (size_t)(it / NG) * NG * 256 * 512, WSB(bf16, WS_WY) + (size_t)(it / NG) * NG * 512 * KX);
    GRID_BAR();
    row_mod_pass(IN(0), WSB(bf16, WS_H), WSB(bf16, WS_YB), WSB(float, WS_MODS), 0 * DM, 1 * DM, gw, ngw);
    GRID_BAR();

#pragma unroll 1
    for (int l = 0; l < DEPTH; ++l) {
        { pg8::Gemm g = pg8::gemm_rm(WSB(bf16, WS_H), WSB(bf16, WS_WIN) + (size_t)l * INW * DM, DM); pg8::StaticOrder S; S.init(M, INW, G, (int)blockIdx.x);
          pg8::EpiQKVU E{WSB(bf16, WS_QKV), (size_t)M * AW, at3::QSCALE, WSB(bf16, WS_UX), NCHUNK};
          pg8::gemm_phase<pg8::EpiQKVU, pg8::StaticOrder, true, true>(lds + RING_OFF, g, S, E); }
        GRID_BAR();
        { pg8::Gemm g{WSB(bf16, WS_UX), WSB(bf16, WS_BST) + (size_t)l * NG * 256 * 512, 512, KX, 16, 512}; pg8::GroupOrder S; S.init(NG, 4, 1, G, vcu);
          pg8::EpiStateF32 E{WSB(float, WS_S)};
          pg8::gemm_phase<pg8::EpiStateF32, pg8::GroupOrder, true, true>(lds + RING_OFF, g, S, E); }
        GRID_BAR();
        ssm_scan_coop(l, WSB(float, WS_S), WSB(bf16, WS_UX), lds + RING_OFF, vcu, G, wave);
        __syncthreads();
        at3::attn_phase(WSB(bf16, WS_QKV), WSB(bf16, WS_QKV) + (size_t)M * AW, WSB(bf16, WS_QKV) + (size_t)2 * M * AW, WSB(bf16, WS_MRG), WSB(float, WS_SSQP), lds + RING_OFF, vcu, G, wave);
        GRID_BAR();
        { pg8::Gemm g{WSB(bf16, WS_UX), WSB(bf16, WS_WY) + (size_t)l * NG * 512 * KX, KX, KX, 16, KX}; pg8::GroupOrder S; S.init(NG, 4, 2, G, vcu);
          pg8::EpiSsmY E{WSB(bf16, WS_YACT)};
          pg8::gemm_phase<pg8::EpiSsmY, pg8::GroupOrder, true, true>(lds + RING_OFF, g, S, E); }
        GRID_BAR();
        { pg8::Gemm g{WSB(bf16, WS_YACT), WSB(bf16, WS_WGLU) + (size_t)l * SW * SW, SW, 16, M * 16, SW}; pg8::StaticOrder S; S.init(M, SW, G, (int)blockIdx.x);
          pg8::EpiGluG E{WSB(bf16, WS_YACT), (size_t)M * 16, WSB(bf16, WS_MRG), DM, AW, IN(14) + (size_t)l * SW, WSB(float, WS_SSQP) + (size_t)M * 16};
          pg8::gemm_phase<pg8::EpiGluG, pg8::StaticOrder, true, true>(lds + RING_OFF, g, S, E); }
        GRID_BAR();
        row_factor_pass(WSB(float, WS_SSQP), WSB(float, WS_RF), vcu * NWAVES * 64, G * NWAVES * 64);
        GRID_BAR();
        { pg8::Gemm g = pg8::gemm_rm(WSB(bf16, WS_MRG), WSB(bf16, WS_WOUT) + (size_t)l * DM * DM, DM); pg8::StaticOrder S; S.init(M, DM, G, (int)blockIdx.x);
          pg8::EpiResidT<true> E{l, 0, WS_MODS, WS_STATS, WS_YB, WS_RF, DM, NMOD, SEQ, ALPHA, WS_LNCNT};
          pg8::gemm_phase<pg8::EpiResidT<true>, pg8::StaticOrder, true, true>(lds + RING_OFF, g, S, E); }
        ln_queue_pass(lds, l * 2, WSB(bf16, WS_YB), WSB(bf16, WS_H), nullptr, WSB(float, WS_STATS), IN(18) + (size_t)l * DM, IN(19) + (size_t)l * DM, WSB(float, WS_MODS) + (size_t)l * BATCH * NMOD, 3 * DM, 4 * DM, G);
        GRID_BAR();
        { pg8::Gemm g = pg8::gemm_rm(WSB(bf16, WS_H), WSB(bf16, WS_W1) + (size_t)l * FF * DM, DM); pg8::StaticOrder S; S.init(M, FF, G, (int)blockIdx.x);
          pg8::EpiBf16<2> E{WSB(bf16, WS_HID), FF, 0, 0, 1.f};
          pg8::gemm_phase<pg8::EpiBf16<2>, pg8::StaticOrder, true, true>(lds + RING_OFF, g, S, E); }
        GRID_BAR();
        { pg8::Gemm g = pg8::gemm_rm(WSB(bf16, WS_HID), WSB(bf16, WS_W2) + (size_t)l * DM * FF, FF); pg8::StaticOrder S; S.init(M, DM, G, (int)blockIdx.x);
          pg8::EpiResidT<false> E{l, 1, WS_MODS, WS_STATS, WS_YB, WS_RF, DM, NMOD, SEQ, ALPHA, WS_LNCNT};
          pg8::gemm_phase<pg8::EpiResidT<false>, pg8::StaticOrder, true, true>(lds + RING_OFF, g, S, E); }
        ln_queue_pass(lds, l * 2 + 1, WSB(bf16, WS_YB), WSB(bf16, WS_H), (l + 1 == DEPTH) ? OUTP() : nullptr, WSB(float, WS_STATS), IN(22) + (size_t)l * DM, IN(23) + (size_t)l * DM, (l + 1 < DEPTH) ? WSB(float, WS_MODS) + (size_t)(l + 1) * BATCH * NMOD : nullptr, 0 * DM, 1 * DM, G);
        if (l + 1 < DEPTH) GRID_BAR();
    }
}

extern "C" void kernel_launch(void* const* d_in, const int* in_sizes, int n_in, void* d_out, int out_size, void* d_ws, size_t ws_size, hipStream_t stream) {
    static int grid = 0;
    if (grid == 0) {
        if (n_in != 24 || out_size != M * DM || ws_size < WS_END) { fprintf(stderr, "kernel_launch: unexpected shapes (n_in %d out %d ws %zu)\n", n_in, out_size, ws_size); grid = -1; return; }
        int dev = 0, cus = 0, per_cu = 0;
        if (hipGetDevice(&dev) != hipSuccess || hipDeviceGetAttribute(&cus, hipDeviceAttributeMultiprocessorCount, dev) != hipSuccess) { grid = -1; return; }
        if (hipFuncSetAttribute((const void*)mega_fwd, hipFuncAttributeMaxDynamicSharedMemorySize, LDS_BYTES) != hipSuccess) { fprintf(stderr, "kernel_launch: hipFuncSetAttribute failed\n"); grid = -1; return; }
        if (hipOccupancyMaxActiveBlocksPerMultiprocessor(&per_cu, (const void*)mega_fwd, NWAVES * 64, LDS_BYTES) != hipSuccess || per_cu < 1)
            fprintf(stderr, "kernel_launch: note: occupancy query reports %d workgroups per CU\n", per_cu);
        (void)hipGetLastError();
        grid = cus;
    }
    if (grid < 0) return;
    if (hipMemsetAsync((char*)d_ws + WS_CTL, 0, CTL_ZERO_BYTES, stream) != hipSuccess) return;
    Ptrs p{};
    for (int i = 0; i < 24; ++i) p.in[i] = (const float*)d_in[i];
    p.out = (float*)d_out; p.ws = (unsigned char*)d_ws;
    hipLaunchKernelGGL(mega_fwd, dim3(grid), dim3(NWAVES * 64), LDS_BYTES, stream, p);
}
```

```cpp
#include <hip/hip_runtime.h>
#include <cstdio>
#include <cstdint>
#define GAS __attribute__((address_space(1)))
typedef const __attribute__((address_space(4))) unsigned long long* kargp_t;
__device__ __forceinline__ kargp_t karg() { kargp_t kp = (kargp_t)__builtin_amdgcn_kernarg_segment_ptr(); asm volatile("" : "+s"(kp)); return kp; }
__device__ __forceinline__ const float* IN(int i) { return (const float*)(const GAS float*)karg()[i]; }
__device__ __forceinline__ float* OUTP() { return (float*)(GAS float*)karg()[24]; }
__device__ __forceinline__ unsigned char* WSP() { return (unsigned char*)(GAS unsigned char*)karg()[25]; }
#define WSB(T, off) ((T*)(WSP() + (off)))
__device__ __forceinline__ float fsum_x16x32(float v) {
    { auto r = __builtin_amdgcn_permlane16_swap(__float_as_uint(v), __float_as_uint(v), false, false); v = __uint_as_float(r[0]) + __uint_as_float(r[1]); }
    { auto r = __builtin_amdgcn_permlane32_swap(__float_as_uint(v), __float_as_uint(v), false, false); v = __uint_as_float(r[0]) + __uint_as_float(r[1]); }
    return v;
}
namespace pg8 {
#define PG8_LAS __attribute__((address_space(3)))
typedef unsigned short bf16_t;
typedef short bf16x8 __attribute__((ext_vector_type(8)));
typedef float f32x4 __attribute__((ext_vector_type(4)));
typedef unsigned u32x4 __attribute__((ext_vector_type(4)));
constexpr int BM = 256, BK = 64, HALF = 128, HTB = HALF * BK * 2  , STAGE_BYTES = 8 * HTB, NXCD = 8;

__host__ __device__ __forceinline__ int lds_byte(int r, int c) { const int st = (r >> 4) * 2 + (c >> 5), rr = r & 15, cc = c & 31, ob = rr * 64 + cc * 2; return st * 1024 + (ob ^ (((ob >> 9) & 1) << 5)); }
__host__ __device__ __forceinline__ void stage_rc(int b, int& R, int& C) { const int st = b / 1024, sb = b % 1024, swz = sb ^ (((sb >> 9) & 1) << 5); R = (st >> 1) * 16 + swz / 64; C = (st & 1) * 32 + (swz % 64) / 2; }
__host__ __device__ __forceinline__ int perm32(int rho) { const int n = rho >> 4, i = rho & 15; return 8 * (i >> 2) + 4 * n + (i & 3); }

struct Unit { int pm, pn; };
struct Gemm { const bf16_t* A; const bf16_t* Bt; int K; int ars, aks, ldb; };
__host__ __device__ __forceinline__ Gemm gemm_rm(const bf16_t* A, const bf16_t* Bt, int K) { return Gemm{A, Bt, K, K, 16, K}; }

struct StaticOrder {
    int nM, nN, nwg, G, c, WGM;
    __host__ __device__ void init(int M, int N, int G_, int c_, int wgm = 4) { nM = M / BM; nN = N / BM; nwg = nM * nN; G = G_; c = c_; WGM = wgm; }
    __host__ __device__ bool next(int i, Unit& u) const {
        const long L = (long)i * G + c; if (L >= nwg) return false;
        int wgid = (int)L; { const int q = nwg / NXCD, r = nwg % NXCD, xcd = wgid % NXCD, off = wgid / NXCD; wgid = (xcd < r ? xcd * (q + 1) : r * (q + 1) + (xcd - r) * q) + off; }
        const int nig = WGM * nN, gid = wgid / nig, fm = gid * WGM, gsz = (nM - fm) < WGM ? (nM - fm) : WGM;
        u.pm = fm + ((wgid % nig) % gsz); u.pn = (wgid % nig) / gsz; return true;
    }
    __device__ __forceinline__ void a_ready(const Unit&) const {}
    __device__ __forceinline__ void done(const Unit&) const {}
};

struct StaticOrderDep : StaticOrder {
    size_t cnt_off; unsigned need;
    __device__ __forceinline__ void a_ready(const Unit& u) const {
        const __attribute__((address_space(1))) unsigned* c = (const __attribute__((address_space(1))) unsigned*)(WSP() + cnt_off) + u.pm;
        for (unsigned spins = 0; (unsigned)__builtin_amdgcn_readfirstlane(__hip_atomic_load(c, __ATOMIC_RELAXED, __HIP_MEMORY_SCOPE_AGENT)) != need && spins < (1u << 24); ++spins) __builtin_amdgcn_s_sleep(4);
    }
};
__device__ __forceinline__ unsigned cvt_pk_bf16(float lo, float hi) { unsigned r; asm volatile("v_cvt_pk_bf16_f32 %0, %1, %2" : "=v"(r) : "v"(lo), "v"(hi)); return r; }
typedef float f32x2 __attribute__((ext_vector_type(2)));
template <class E> struct perm2_of { static constexpr bool v = false; };
template <int DPPC> __device__ __forceinline__ u32x4 dpp4(const u32x4& x) { u32x4 r; r.x = (unsigned)__builtin_amdgcn_update_dpp(0, (int)x.x, DPPC, 0xF, 0xF, true); r.y = (unsigned)__builtin_amdgcn_update_dpp(0, (int)x.y, DPPC, 0xF, 0xF, true);
    r.z = (unsigned)__builtin_amdgcn_update_dpp(0, (int)x.z, DPPC, 0xF, 0xF, true); r.w = (unsigned)__builtin_amdgcn_update_dpp(0, (int)x.w, DPPC, 0xF, 0xF, true); return r; }
__device__ __forceinline__ u32x4 sel4(bool c, const u32x4& a, const u32x4& b) { u32x4 r; r.x = c ? a.x : b.x; r.y = c ? a.y : b.y; r.z = c ? a.z : b.z; r.w = c ? a.w : b.w; return r; }
template <int ACT, bool CNT = false> struct EpiBf16 {
    static constexpr bool PERM = true, AFTER_DRAIN = false; static constexpr bool MIDK = false;
    bf16_t* O; int ldc; int split_cols; size_t split_stride; float scale0; size_t cnt_off = 0;
    __device__ __forceinline__ void count_in(const Unit& u) const {
        if (threadIdx.x == 0) __hip_atomic_fetch_add((GAS unsigned*)(WSP() + cnt_off) + u.pm, 1u, __ATOMIC_RELAXED, __HIP_MEMORY_SCOPE_AGENT); }
    __device__ __forceinline__ void operator()(const f32x4 (&acc)[2][2][4][2], const Unit& u, int wr, int wc, int fr, int fq) const {
        const int row0 = u.pm * BM + wr * 64 + fr; int colt = u.pn * BM; bf16_t* base = O;
        float sc = 1.f; if (split_cols) { const int t = colt / split_cols; base += (size_t)t * split_stride; colt -= t * split_cols; if (t == 0) sc = scale0; }
        if constexpr (ACT == 2) {
            const bool even = (fr & 1) == 0;
            const int colA = colt + wc * 64 + 8 * fq + (even ? 0 : 32);
            const long offA = (long)(row0 - (even ? 0 : 1)) * ldc + colA, offB = (long)(row0 + (even ? 1 : 0)) * ldc + colA;
#pragma unroll
            for (int ai = 0; ai < 2; ++ai)
#pragma unroll
                for (int m = 0; m < 4; ++m) { u32x4 w[2];
#pragma unroll
                    for (int bj = 0; bj < 2; ++bj) { f32x4 v0 = acc[ai][bj][m][0], v1 = acc[ai][bj][m][1];
#pragma unroll
                        for (int e = 0; e < 4; ++e) { const float a = fmaxf(v0[e], 0.f), b = fmaxf(v1[e], 0.f); v0[e] = a * a; v1[e] = b * b; }
                        v0 = v0 * sc; v1 = v1 * sc; w[bj].x = cvt_pk_bf16(v0[0], v0[1]); w[bj].y = cvt_pk_bf16(v0[2], v0[3]); w[bj].z = cvt_pk_bf16(v1[0], v1[1]); w[bj].w = cvt_pk_bf16(v1[2], v1[3]); }
                    const u32x4 recv = dpp4<0xB1>(sel4(even, w[1], w[0]));
                    const size_t ro = (size_t)(ai * HALF + m * 16) * ldc;
                    *(u32x4*)(base + offA + ro) = sel4(even, w[0], recv);
                    *(u32x4*)(base + offB + ro) = sel4(even, recv, w[1]); }
        } else {
        const int col0 = colt + wc * 32 + 8 * fq;
#pragma unroll
        for (int ai = 0; ai < 2; ++ai)
#pragma unroll
            for (int m = 0; m < 4; ++m) { bf16_t* rowp = base + (size_t)(row0 + ai * HALF + m * 16) * ldc + col0;
#pragma unroll
                for (int bj = 0; bj < 2; ++bj) { f32x4 v0 = acc[ai][bj][m][0], v1 = acc[ai][bj][m][1];
                    v0 = v0 * sc; v1 = v1 * sc; u32x4 w; w.x = cvt_pk_bf16(v0[0], v0[1]); w.y = cvt_pk_bf16(v0[2], v0[3]); w.z = cvt_pk_bf16(v1[0], v1[1]); w.w = cvt_pk_bf16(v1[2], v1[3]);
                    *(u32x4*)(rowp + bj * HALF) = w; } }
        }
    }
};
template <bool CNT> struct perm2_of<EpiBf16<2, CNT>> { static constexpr bool v = true; };
__device__ __forceinline__ float bf_lo(unsigned w) { return __uint_as_float(w << 16); }
__device__ __forceinline__ float bf_hi(unsigned w) { return __uint_as_float(w & 0xffff0000u); }
typedef _Float16 f16x8 __attribute__((ext_vector_type(8)));
__device__ __forceinline__ u32x4 pack_f16x8(const f32x4& a, const f32x4& b) { f16x8 h = {(_Float16)a[0], (_Float16)a[1], (_Float16)a[2], (_Float16)a[3], (_Float16)b[0], (_Float16)b[1], (_Float16)b[2], (_Float16)b[3]}; return __builtin_bit_cast(u32x4, h); }
__device__ __forceinline__ void unpack_f16x8(const u32x4& w, f32x4& a, f32x4& b) { const f16x8 h = __builtin_bit_cast(f16x8, w); a = (f32x4){(float)h[0], (float)h[1], (float)h[2], (float)h[3]}; b = (f32x4){(float)h[4], (float)h[5], (float)h[6], (float)h[7]}; }
template <bool MIX> struct EpiResidT {
    static constexpr bool PERM = true, AFTER_DRAIN = false; static constexpr bool MIDK = MIX;
    int l, sub;
    size_t mods_off, stats_off, yb_off, ssq_off; int ldc, gstride, rows_per_batch; float alpha;
    size_t cnt_off;
    __device__ __forceinline__ void midk(f32x4 (&acc)[2][2][4][2], const Unit& u, int wr, int wc, int fr, int fq) const {
        const f32x2* rf = (const f32x2*)(WSP() + ssq_off); const int row0 = u.pm * BM + wr * 64 + fr;
        float ratio[8];
#pragma unroll
        for (int i = 0; i < 8; ++i) ratio[i] = rf[row0 + (i >> 2) * HALF + (i & 3) * 16].x;
#pragma unroll
        for (int i = 0; i < 8; ++i)
#pragma unroll
            for (int bj = 0; bj < 2; ++bj)
#pragma unroll
                for (int n = 0; n < 2; ++n) acc[i >> 2][bj][i & 3][n] = acc[i >> 2][bj][i & 3][n] * ratio[i];
    }
    __device__ __forceinline__ void count_in(const Unit& u) const {
        if (threadIdx.x == 0) __hip_atomic_fetch_add((GAS unsigned*)(WSP() + cnt_off) + (l * 2 + sub) * 128 + u.pm, 1u, __ATOMIC_RELAXED, __HIP_MEMORY_SCOPE_AGENT); }
    __device__ __forceinline__ void operator()(const f32x4 (&acc)[2][2][4][2], const Unit& u, int wr, int wc, int fr, int fq) const {
        const int row0 = u.pm * BM + wr * 64 + fr, col0 = u.pn * BM + wc * 32 + 8 * fq;
        const int b = (u.pm * BM) / rows_per_batch;
        const bool first = (l == 0 && sub == 0);
        bf16_t* YB = (bf16_t*)(WSP() + yb_off);
        const float* gate = (const float*)(WSP() + mods_off) + (size_t)l * 4 * gstride + (sub == 0 ? 2 : 5) * ldc;
        const float* stats = (const float*)(WSP() + stats_off);
        const int ll = sub == 0 ? (l > 0 ? l - 1 : 0) : l;
        const float* lg = IN(sub == 0 ? 22 : 18) + (size_t)ll * ldc; const float* lb = IN(sub == 0 ? 23 : 19) + (size_t)ll * ldc;
        f32x4 gv[2][2], gm[2][2], bt[2][2];
#pragma unroll
        for (int bj = 0; bj < 2; ++bj)
#pragma unroll
            for (int n = 0; n < 2; ++n) { gv[bj][n] = *(const f32x4*)(gate + (size_t)b * gstride + col0 + bj * HALF + n * 4) + 1.0f;
                if (!first) { gm[bj][n] = *(const f32x4*)(lg + col0 + bj * HALF + n * 4) * alpha; bt[bj][n] = *(const f32x4*)(lb + col0 + bj * HALF + n * 4) * alpha; }
                else { gm[bj][n] = (f32x4){alpha, alpha, alpha, alpha}; bt[bj][n] = (f32x4){0.f, 0.f, 0.f, 0.f}; } }
        const bf16_t* __restrict__ Yr = YB; bf16_t* __restrict__ Yw = YB;
#pragma unroll
        for (int aq = 0; aq < 4; ++aq) { const int ai = aq >> 1, mb_ = (aq & 1) * 2;
            f32x4 xv[2][2][2]; float mean[2], rstd[2], rsm[2];
            { u32x4 w[2][2];
#pragma unroll
                for (int mm = 0; mm < 2; ++mm) { const int r = row0 + ai * HALF + (mb_ + mm) * 16; const size_t off = (size_t)r * ldc + col0;
                    mean[mm] = 0.f; rstd[mm] = 1.f; if (!first) { const f32x2 st = *(const f32x2*)(stats + 2 * (size_t)r); mean[mm] = st.x; rstd[mm] = st.y; }
                    rsm[mm] = 1.f; if constexpr (MIX) rsm[mm] = ((const f32x2*)(WSP() + ssq_off))[r].y;
#pragma unroll
                    for (int bj = 0; bj < 2; ++bj) w[mm][bj] = *(const u32x4*)(Yr + off + bj * HALF); }
#pragma unroll
                for (int mm = 0; mm < 2; ++mm)
#pragma unroll
                    for (int bj = 0; bj < 2; ++bj) unpack_f16x8(w[mm][bj], xv[mm][bj][0], xv[mm][bj][1]); }
#pragma unroll
            for (int mm = 0; mm < 2; ++mm) { const int m = mb_ + mm; const int r = row0 + ai * HALF + m * 16; const size_t off = (size_t)r * ldc + col0;
#pragma unroll
                for (int bj = 0; bj < 2; ++bj) { f32x4 y[2];
#pragma unroll
                    for (int n = 0; n < 2; ++n) y[n] = ((xv[mm][bj][n] - mean[mm]) * rstd[mm]) * gm[bj][n] + bt[bj][n] + gv[bj][n] * (acc[ai][bj][m][n] * rsm[mm]);
                    { const u32x4 pk_ = pack_f16x8(y[0], y[1]); bf16_t* sp_ = Yw + off + bj * HALF;
                      asm volatile("global_store_dwordx4 %0, %1, off sc1\n\ts_nop 1" :: "v"(sp_), "v"(pk_) : "memory"); } } }
            asm volatile("" ::: "memory"); }
    }
};

template <class E> struct has_cnt { static constexpr bool v = false; };
template <bool MIX> struct has_cnt<EpiResidT<MIX>> { static constexpr bool v = true; };
template <int ACT> struct has_cnt<EpiBf16<ACT, true>> { static constexpr bool v = true; };

struct EpiQKVU {
    static constexpr bool PERM = true, AFTER_DRAIN = false; static constexpr bool MIDK = false;
    bf16_t* O; size_t split_stride; float scale0; bf16_t* UX; int nchunk;
    __device__ __forceinline__ void operator()(const f32x4 (&acc)[2][2][4][2], const Unit& u, int wr, int wc, int fr, int fq) const {
        const int row0 = u.pm * BM + wr * 64 + fr; const int t = (u.pn * BM) >> 10; const int colt = (u.pn * BM) & 1023;
        const float sc = (t == 0) ? scale0 : 1.f;
        const int col0 = colt + wc * 32 + 8 * fq;
#pragma unroll
        for (int ai = 0; ai < 2; ++ai)
#pragma unroll
            for (int m = 0; m < 4; ++m) { const int r = row0 + ai * HALF + m * 16;
#pragma unroll
                for (int bj = 0; bj < 2; ++bj) { f32x4 v0 = acc[ai][bj][m][0] * sc, v1 = acc[ai][bj][m][1] * sc;
                    u32x4 w; w.x = cvt_pk_bf16(v0[0], v0[1]); w.y = cvt_pk_bf16(v0[2], v0[3]); w.z = cvt_pk_bf16(v1[0], v1[1]); w.w = cvt_pk_bf16(v1[2], v1[3]);
                    const int col = col0 + bj * HALF;
                    bf16_t* p = (t == 0) ? O + (size_t)r * 1024 + col
                              : (t < 3) ? O + (size_t)t * split_stride + ((size_t)(col >> 6) * (split_stride >> 10) + r) * 64 + (col & 63)
                                        : UX + ((size_t)(col >> 4) * nchunk + (r >> 5)) * 768 + (r & 31) * 16 + (col & 15);
                    *(u32x4*)p = w; } }
    }
};
struct EpiStateF32 {
    static constexpr bool PERM = false, AFTER_DRAIN = false; static constexpr bool MIDK = false;
    float* C;
    __device__ __forceinline__ void operator()(const f32x4 (&acc)[2][2][4][2], const Unit& u, int wr, int wc, int fr, int fq) const {
        const int row0 = u.pm * BM + wr * 64 + fr, col0 = wc * 32 + 4 * fq;
#pragma unroll
        for (int ai = 0; ai < 2; ++ai)
#pragma unroll
            for (int m = 0; m < 4; ++m) { float* rowp = C + (size_t)(row0 + ai * HALF + m * 16) * 256 + col0;
#pragma unroll
                for (int bj = 0; bj < 2; ++bj)
#pragma unroll
                    for (int n = 0; n < 2; ++n) *(f32x4*)(rowp + bj * HALF + n * 16) = acc[ai][bj][m][n]; }
    }
};
__device__ __forceinline__ float gelu_tanh_f(float x) { const float z = 0.7978845608028654f * (x + 0.044715f * x * x * x); return x * __builtin_amdgcn_rcpf(1.f + __expf(-2.f * z)); }
struct EpiSsmY {
    static constexpr bool PERM = true, AFTER_DRAIN = false; static constexpr bool MIDK = false;
    bf16_t* O;
    __device__ __forceinline__ void operator()(const f32x4 (&acc)[2][2][4][2], const Unit& u, int wr, int wc, int fr, int fq) const {
        const int row0 = u.pm * BM + wr * 64 + fr, col0 = (u.pn & 1) * BM + wc * 32 + 8 * fq;
#pragma unroll
        for (int ai = 0; ai < 2; ++ai)
#pragma unroll
            for (int m = 0; m < 4; ++m) { bf16_t* rowp = O + (size_t)(row0 + ai * HALF + m * 16) * 512 + col0;
#pragma unroll
                for (int bj = 0; bj < 2; ++bj) { const f32x4 v0 = acc[ai][bj][m][0], v1 = acc[ai][bj][m][1];
                    u32x4 w; w.x = cvt_pk_bf16(gelu_tanh_f(v0[0]), gelu_tanh_f(v0[1])); w.y = cvt_pk_bf16(gelu_tanh_f(v0[2]), gelu_tanh_f(v0[3]));
                    w.z = cvt_pk_bf16(gelu_tanh_f(v1[0]), gelu_tanh_f(v1[1])); w.w = cvt_pk_bf16(gelu_tanh_f(v1[2]), gelu_tanh_f(v1[3]));
                    *(u32x4*)(rowp + bj * HALF) = w; } }
    }
};
struct EpiGluG {
    static constexpr bool PERM = true, AFTER_DRAIN = false; static constexpr bool MIDK = false;
    const bf16_t* S; size_t gstride; bf16_t* O; int ldo; int ocol; const float* bias; float* ssq;
    __device__ __forceinline__ void operator()(const f32x4 (&acc)[2][2][4][2], const Unit& u, int wr, int wc, int fr, int fq) const {
        const int row0 = u.pm * BM + wr * 64 + fr; const int col0 = u.pn * BM + wc * 32 + 8 * fq;
        f32x4 bv[2][2];
#pragma unroll
        for (int bj = 0; bj < 2; ++bj)
#pragma unroll
            for (int n = 0; n < 2; ++n) bv[bj][n] = *(const f32x4*)(bias + col0 + bj * HALF + 4 * n);
        const bf16_t* __restrict__ Sr = S; bf16_t* __restrict__ Or = O;
#pragma unroll
        for (int ai = 0; ai < 2; ++ai) {
            u32x4 sv[4][2]; float sq[4] = {0.f, 0.f, 0.f, 0.f};
#pragma unroll
            for (int m = 0; m < 4; ++m) { const size_t r = (size_t)(row0 + ai * HALF + m * 16);
#pragma unroll
                for (int bj = 0; bj < 2; ++bj) { const int col = col0 + bj * HALF; sv[m][bj] = *(const u32x4*)(Sr + (size_t)(col >> 4) * gstride + r * 16 + (col & 15)); } }
#pragma unroll
            for (int m = 0; m < 4; ++m) { const size_t r = (size_t)(row0 + ai * HALF + m * 16);
#pragma unroll
                for (int bj = 0; bj < 2; ++bj) { const f32x4 z0 = acc[ai][bj][m][0] + bv[bj][0], z1 = acc[ai][bj][m][1] + bv[bj][1];
                    const int col = col0 + bj * HALF; const u32x4 w_ = sv[m][bj];
                    float s[8] = {bf_lo(w_.x), bf_hi(w_.x), bf_lo(w_.y), bf_hi(w_.y), bf_lo(w_.z), bf_hi(w_.z), bf_lo(w_.w), bf_hi(w_.w)};
                    float o[8];
#pragma unroll
                    for (int e = 0; e < 4; ++e) { o[e] = s[e] * __builtin_amdgcn_rcpf(1.f + __expf(-z0[e])); o[4 + e] = s[4 + e] * __builtin_amdgcn_rcpf(1.f + __expf(-z1[e])); }
                    u32x4 w; w.x = cvt_pk_bf16(o[0], o[1]); w.y = cvt_pk_bf16(o[2], o[3]); w.z = cvt_pk_bf16(o[4], o[5]); w.w = cvt_pk_bf16(o[6], o[7]);
#pragma unroll
                    for (int e2 = 0; e2 < 8; ++e2) sq[m] += o[e2] * o[e2];
                    *(u32x4*)(Or + r * ldo + ocol + col) = w; } }
#pragma unroll
            for (int m = 0; m < 4; ++m) { float q = sq[m]; q = fsum_x16x32(q);
                if (fq == 0) ssq[(size_t)(row0 + ai * HALF + m * 16) * 16 + 4 * u.pn + wc] = q; }
            asm volatile("" ::: "memory"); }
    }
};
struct GroupOrder {
    int nMg, nNg, nwg, G, c;
    __host__ __device__ void init(int ngroups, int nMg_, int nNg_, int G_, int c_) { nMg = nMg_; nNg = nNg_; nwg = ngroups * nMg_ * nNg_; G = G_; c = c_; }
    __host__ __device__ bool next(int i, Unit& u) const {
        const long L = (long)i * G + c; if (L >= nwg) return false;
        const int per = nMg * nNg, g = (int)L / per, r = (int)L % per;
        u.pm = g * nMg + r / nNg; u.pn = g * nNg + r % nNg; return true;
    }
    __device__ __forceinline__ void a_ready(const Unit&) const {}
    __device__ __forceinline__ void done(const Unit&) const {}
};

template <class Epi, class Sched, bool ALIGN_EPI = false, bool SP2 = false>
__device__ __forceinline__ void gemm_phase(PG8_LAS unsigned char* lds, const Gemm g, const Sched& S, const Epi& E) {
    int tid_ = threadIdx.x; asm volatile("" : "+v"(tid_));
    const int tid = tid_, wid = __builtin_amdgcn_readfirstlane(tid >> 6), lane = tid & 63, wr = wid >> 2, wc = wid & 3, fr = lane & 15, fq = lane >> 4;
    const int K = g.K, nt = K / BK;
    unsigned voffA[2], voffB[2];
#pragma unroll
    for (int i = 0; i < 2; ++i) { int R, C; stage_rc(tid * 16 + i * 8192, R, C); const int Rb = perm2_of<Epi>::v ? ((R >> 5) * 64 + perm32(R & 31)) : (Epi::PERM ? ((R & ~31) + perm32(R & 31)) : R);
        voffA[i] = (unsigned)(R * g.ars + (C >> 4) * g.aks + (C & 15)) * 2u; voffB[i] = (unsigned)(Rb * g.ldb + C) * 2u; }
    const size_t kstepA = (size_t)g.aks * 8, kstepB = (size_t)(BK * 2);
    const size_t hstepA = (size_t)HALF * g.ars * 2, hstepB = (size_t)(perm2_of<Epi>::v ? 32 : HALF) * g.ldb * 2;
    const size_t tstepA = 2 * hstepA, tstepB = (size_t)2 * HALF * g.ldb * 2;
    const unsigned ldsw = (unsigned)wid * 1024u;
    const int aoff = lds_byte(wr * 64 + fr, fq * 8), boff = lds_byte(wc * 32 + fr, fq * 8);
#define PG8_SA(b, h) (((b) * 2 + (h)) * HTB)
#define PG8_SB(b, h) ((4 + (b) * 2 + (h)) * HTB)
#define PG8_STAGE(bufoff, gbase, voff) do { _Pragma("unroll") for (int _i = 0; _i < 2; ++_i) \
        __builtin_amdgcn_global_load_lds((const unsigned*)((const char*)(gbase) + (voff)[_i]), (PG8_LAS unsigned*)(lds + (bufoff) + ldsw + _i * 8192), 16, 0, 0); } while (0)
#define PG8_LDA(dst, b, h) do { _Pragma("unroll") for (int m = 0; m < 4; ++m) _Pragma("unroll") for (int k = 0; k < 2; ++k) dst[m][k] = *(const PG8_LAS bf16x8*)(lds + PG8_SA(b, h) + aoff + m * 2048 + k * 1024); } while (0)
#define PG8_LDB(dst, b, h) do { _Pragma("unroll") for (int n = 0; n < 2; ++n) _Pragma("unroll") for (int k = 0; k < 2; ++k) dst[n][k] = *(const PG8_LAS bf16x8*)(lds + PG8_SB(b, h) + boff + n * 2048 + k * 1024); } while (0)
#define PG8_MMA(ai, bj, At, Bt) do { __builtin_amdgcn_s_setprio(1); _Pragma("unroll") for (int m = 0; m < 4; ++m) _Pragma("unroll") for (int n = 0; n < 2; ++n) _Pragma("unroll") for (int k = 0; k < 2; ++k) \
        acc[ai][bj][m][n] = __builtin_amdgcn_mfma_f32_16x16x32_bf16(Bt[n][k], At[m][k], acc[ai][bj][m][n], 0, 0, 0); __builtin_amdgcn_s_setprio(0); } while (0)
#define PG8_WAIT_V(n) asm volatile("s_waitcnt vmcnt(" #n ")" ::: "memory")
#define PG8_WAIT_L(n) asm volatile("s_waitcnt lgkmcnt(" #n ")" ::: "memory")
#define PG8_BAR __builtin_amdgcn_s_barrier()
#define PG8_SCHED __builtin_amdgcn_sched_barrier(0)
    Unit cur, nxt, prv; int ui = 0;
    if (!S.next(0, cur)) return;
    prv = cur;
    bf16x8 At[4][2], B0[2][2], B1[2][2];
    const char* cA = (const char*)g.A + (size_t)cur.pm * tstepA; const char* cB = (const char*)g.Bt + (size_t)cur.pn * tstepB;
    S.a_ready(cur);
    if constexpr (SP2) {
        PG8_STAGE(PG8_SB(0, 0), cB, voffB); PG8_STAGE(PG8_SB(0, 1), cB + hstepB, voffB); PG8_STAGE(PG8_SA(0, 0), cA, voffA); PG8_STAGE(PG8_SA(0, 1), cA + hstepA, voffA);
        if (wr == 1) PG8_BAR;
        PG8_WAIT_V(2); PG8_BAR;
        PG8_STAGE(PG8_SB(1, 0), cB + kstepB, voffB); PG8_STAGE(PG8_SA(1, 0), cA + kstepA, voffA); PG8_STAGE(PG8_SB(1, 1), cB + hstepB + kstepB, voffB);
        PG8_WAIT_V(6); PG8_BAR;
    } else {
        PG8_STAGE(PG8_SB(0, 0), cB, voffB); PG8_STAGE(PG8_SA(0, 0), cA, voffA); PG8_STAGE(PG8_SB(0, 1), cB + hstepB, voffB); PG8_STAGE(PG8_SA(0, 1), cA + hstepA, voffA);
        if (wr == 1) PG8_BAR;
        PG8_WAIT_V(4); PG8_BAR;
        PG8_STAGE(PG8_SB(1, 0), cB + kstepB, voffB); PG8_STAGE(PG8_SA(1, 0), cA + kstepA, voffA); PG8_STAGE(PG8_SB(1, 1), cB + hstepB + kstepB, voffB);
        PG8_WAIT_V(6); PG8_BAR;
    }
    for (;;) {
        const bool has_next = S.next(ui + 1, nxt);
        f32x4 acc[2][2][4][2];
#pragma unroll
        for (int a = 0; a < 2; ++a)
#pragma unroll
            for (int b = 0; b < 2; ++b)
#pragma unroll
                for (int m = 0; m < 4; ++m)
#pragma unroll
                    for (int n = 0; n < 2; ++n) acc[a][b][m][n] = (f32x4){0.f, 0.f, 0.f, 0.f};
        const char* nA = has_next ? (const char*)g.A + (size_t)nxt.pm * tstepA : cA; const char* nB = has_next ? (const char*)g.Bt + (size_t)nxt.pn * tstepB : cB;
#pragma unroll 1
        for (int kh = 0; kh < 2; ++kh) {
        for (int t = kh * (nt >> 1); t < (kh + 1) * (nt >> 1); t += 2) {
            const bool last = (t == nt - 2);
            const char* a1 = cA + (size_t)(t + 1) * kstepA;
            const char* a2 = last ? nA : cA + (size_t)(t + 2) * kstepA; const char* b2 = last ? nB : cB + (size_t)(t + 2) * kstepB;
            const char* a3 = a2 + kstepA; const char* b3 = b2 + kstepB;
            if (last && has_next) S.a_ready(nxt);
            if constexpr (SP2) {
            PG8_LDB(B0, 0, 0); PG8_LDB(B1, 0, 1); PG8_SCHED; PG8_LDA(At, 0, 0); PG8_STAGE(PG8_SA(1, 1), a1 + hstepA, voffA);
            PG8_WAIT_V(8); PG8_WAIT_L(0); PG8_BAR; PG8_MMA(0, 0, At, B0); PG8_MMA(0, 1, At, B1); PG8_BAR; PG8_SCHED;
            PG8_LDA(At, 0, 1); PG8_STAGE(PG8_SB(0, 0), b2, voffB); PG8_STAGE(PG8_SB(0, 1), b2 + hstepB, voffB); PG8_STAGE(PG8_SA(0, 0), a2, voffA);
            PG8_WAIT_V(8); PG8_WAIT_L(0); PG8_BAR; PG8_MMA(1, 0, At, B0); PG8_MMA(1, 1, At, B1); PG8_BAR; PG8_SCHED;
            PG8_LDB(B0, 1, 0); PG8_LDB(B1, 1, 1); PG8_SCHED; PG8_LDA(At, 1, 0); PG8_STAGE(PG8_SA(0, 1), a2 + hstepA, voffA);
            PG8_WAIT_V(8); PG8_WAIT_L(0); PG8_BAR; PG8_MMA(0, 0, At, B0); PG8_MMA(0, 1, At, B1); PG8_BAR; PG8_SCHED;
            PG8_LDA(At, 1, 1); PG8_STAGE(PG8_SB(1, 0), b3, voffB); PG8_STAGE(PG8_SB(1, 1), b3 + hstepB, voffB); PG8_STAGE(PG8_SA(1, 0), a3, voffA);
            PG8_WAIT_V(8); PG8_WAIT_L(0); PG8_BAR; PG8_MMA(1, 0, At, B0); PG8_MMA(1, 1, At, B1); PG8_BAR; PG8_SCHED;
            } else {
            PG8_LDB(B0, 0, 0); PG8_SCHED; PG8_LDA(At, 0, 0); PG8_STAGE(PG8_SA(1, 1), a1 + hstepA, voffA);
            PG8_WAIT_L(8); PG8_BAR; PG8_WAIT_L(0); PG8_MMA(0, 0, At, B0); PG8_BAR; PG8_SCHED;
            PG8_LDB(B1, 0, 1); PG8_STAGE(PG8_SB(0, 0), b2, voffB);
            PG8_BAR; PG8_WAIT_L(0); PG8_MMA(0, 1, At, B1); PG8_BAR;
            PG8_LDA(At, 0, 1); PG8_STAGE(PG8_SA(0, 0), a2, voffA);
            PG8_BAR; PG8_WAIT_L(0); PG8_MMA(1, 0, At, B0); PG8_BAR; PG8_SCHED;
            PG8_STAGE(PG8_SB(0, 1), b2 + hstepB, voffB);
            PG8_WAIT_V(6); PG8_BAR; PG8_MMA(1, 1, At, B1); PG8_BAR;
            PG8_LDB(B0, 1, 0); PG8_SCHED; PG8_LDA(At, 1, 0); PG8_STAGE(PG8_SA(0, 1), a2 + hstepA, voffA);
            PG8_WAIT_L(8); PG8_BAR; PG8_WAIT_L(0); PG8_MMA(0, 0, At, B0); PG8_BAR; PG8_SCHED;
            PG8_LDB(B1, 1, 1); PG8_STAGE(PG8_SB(1, 0), b3, voffB);
            PG8_BAR; PG8_WAIT_L(0); PG8_MMA(0, 1, At, B1); PG8_BAR;
            PG8_LDA(At, 1, 1); PG8_STAGE(PG8_SA(1, 0), a3, voffA);
            PG8_BAR; PG8_WAIT_L(0); PG8_MMA(1, 0, At, B0); PG8_BAR; PG8_SCHED;
            PG8_STAGE(PG8_SB(1, 1), b3 + hstepB, voffB);
            PG8_WAIT_V(6); PG8_BAR; PG8_MMA(1, 1, At, B1); PG8_BAR;
            }
        }
        if constexpr (Epi::MIDK) { if (kh == 0) E.midk(acc, cur, wr, wc, fr, fq); }
        }
        if constexpr (ALIGN_EPI) { if (wr == 0) PG8_BAR; }
        if constexpr (has_cnt<Epi>::v) { if (ui > 0) E.count_in(prv); prv = cur; }
        if constexpr (!Epi::AFTER_DRAIN) { E(acc, cur, wr, wc, fr, fq); S.done(cur); }
        if (!has_next) break;
        cur = nxt; cA = nA; cB = nB; ++ui;
        if constexpr (ALIGN_EPI) { if (wr == 1) PG8_BAR; }
    }
    PG8_WAIT_V(0);
    if constexpr (!ALIGN_EPI) { if (wr == 0) PG8_BAR; }
    PG8_BAR;
    if constexpr (has_cnt<Epi>::v) E.count_in(cur);
    static_assert(!Epi::AFTER_DRAIN, "after-drain epilogues are not supported by this body");
#undef PG8_SA
#undef PG8_SB
#undef PG8_STAGE
#undef PG8_LDA
#undef PG8_LDB
#undef PG8_MMA
#undef PG8_WAIT_V
#undef PG8_WAIT_L
#undef PG8_BAR
#undef PG8_SCHED
}
}
constexpr int NWAVES = 8;
constexpr int BATCH = 4, SEQ = 8192, DM = 2048, DEPTH = 4;
constexpr int M = BATCH * SEQ;
constexpr int AW = 1024, NH = 16, HD = 64;
constexpr int SW = 1024, SG = 16, SP = 64, NG = 64;
constexpr int INW = 4096, FF = 8192, NMOD = 6 * DM;
constexpr float LN_EPS = 1e-5f;
constexpr float ALPHA = 1.681792830507429f;

constexpr size_t MiB = 1u << 20;
constexpr size_t WS_CTL = 0, CTL_ZERO_BYTES = 1 * MiB;
constexpr size_t WS_RF = 512 * 1024;
constexpr size_t WS_MODS = 1 * MiB;
constexpr size_t WS_STATS = 1 * MiB + 768 * 1024;
constexpr size_t WS_WIN = 2 * MiB;
constexpr size_t WS_WGLU = WS_WIN + 64 * MiB;
constexpr size_t WS_WOUT = WS_WGLU + 8 * MiB;
constexpr size_t WS_W1 = WS_WOUT + 32 * MiB;
constexpr size_t WS_W2 = WS_W1 + 128 * MiB;
constexpr size_t WS_H = WS_W2 + 128 * MiB;
constexpr size_t WS_YB = WS_H + 128 * MiB;
constexpr size_t WS_MRG = WS_YB + 128 * MiB;
constexpr size_t WS_BIG = WS_MRG + 128 * MiB;
constexpr size_t WS_QKV = WS_BIG, WS_UX = WS_BIG + 192 * MiB, WS_S = WS_BIG + 288 * MiB, WS_YACT = WS_BIG + 352 * MiB  , WS_HID = WS_BIG;
constexpr size_t WS_BST = WS_BIG + 512 * MiB;
constexpr size_t WS_WY = WS_BST + 64 * MiB;
constexpr size_t WS_SSQP = WS_WY + 192 * MiB;
constexpr size_t WS_END = WS_SSQP + 4 * MiB;
constexpr size_t WS_LNCNT = 768 * 1024, WS_LNQ = 768 * 1024 + 8192;
constexpr size_t WS_HIDCNT = 768 * 1024 + 16384;
constexpr size_t WS_XCHK = 768 * 1024 + 24576;
constexpr int CW_BAR = 4096;

constexpr int RING_OFF = 0, RING_BYTES = 131072;
constexpr int LDS_BYTES = 163840;
constexpr int LDSCTL_OFF = LDS_BYTES - 1024, MISC_OFF = LDSCTL_OFF + 320;

#define LAS __attribute__((address_space(3)))
typedef unsigned short bf16;
typedef unsigned v4u __attribute__((ext_vector_type(4)));
typedef float f32x4 __attribute__((ext_vector_type(4)));
typedef short bf16x8 __attribute__((ext_vector_type(8)));
typedef GAS unsigned gu32;
typedef GAS unsigned long long gu64;
#define RLX_AGENT __ATOMIC_RELAXED, __HIP_MEMORY_SCOPE_AGENT
#define LDS_WAIT() asm volatile("s_waitcnt lgkmcnt(0)" ::: "memory")
__device__ __forceinline__ unsigned f2bf(float f) { unsigned u = __builtin_bit_cast(unsigned, f); return (u + 0x7fffu + ((u >> 16) & 1u)) >> 16; }
__device__ __forceinline__ unsigned pk2(float lo, float hi) { return f2bf(lo) | (f2bf(hi) << 16); }

#define XB_TMO      128
#define XB_XCNT(j)  (256  + 64 * (j))
#define XB_XSUB(j)  (1280 + 64 * (j))
#define XB_XGEN(j)  (2304 + 64 * (j))
#define XB_TOP      3328
#define XB_TOPGEN   3392
#define XCD_BAR_WORDS 3456
#define XB_SPIN_CAP (1u << 18)

__device__ __forceinline__ unsigned xb_ld(unsigned* p)              { return __hip_atomic_load(p, __ATOMIC_RELAXED, __HIP_MEMORY_SCOPE_AGENT); }
__device__ __forceinline__ unsigned xb_add(unsigned* p, unsigned v) { return __hip_atomic_fetch_add(p, v, __ATOMIC_RELAXED, __HIP_MEMORY_SCOPE_AGENT); }
__device__ __forceinline__ unsigned xb_xcc_id() { return (unsigned)__builtin_amdgcn_s_getreg((3 << 11) | 20) & 0xFu; }
#define XB_SPIN(cond, bar) do { unsigned _sp = 0; while (cond) { __builtin_amdgcn_s_sleep(1); \
    if ((++_sp & 255u) == 0u) { if (xb_ld(&(bar)[XB_TMO])) break; if (_sp > XB_SPIN_CAP) { atomicAdd(&(bar)[XB_TMO], 1u); break; } } } } while (0)

struct XcdBarrier {
    unsigned* bar; unsigned x;
    volatile LAS unsigned* st;
};

__device__ __forceinline__ XcdBarrier xcd_barrier_post(unsigned* bar, volatile LAS unsigned* st) {
    XcdBarrier b; b.bar = bar; b.x = xb_xcc_id(); b.st = st;
    if (threadIdx.x == 0) (void)xb_add(&bar[XB_XCNT(b.x)], 1u);
    return b;
}
__device__ __forceinline__ void xcd_barrier_complete(unsigned* bar, unsigned x, unsigned& nloc, unsigned& nx) {
    const unsigned G = gridDim.x * gridDim.y * gridDim.z;
    unsigned sum, cnt, mine, sp = 0u;
    for (;;) {
        sum = 0u; cnt = 0u; mine = 0u;
#pragma unroll
        for (unsigned j = 0; j < 16; ++j) { const unsigned c = xb_ld(&bar[XB_XCNT(j)]); sum += c; cnt += (c > 0u) ? 1u : 0u; mine = (j == x) ? c : mine; }
        if (sum == G) break;
        __builtin_amdgcn_s_sleep(1);
        if ((++sp & 255u) == 0u) { if (xb_ld(&bar[XB_TMO])) break; if (sp > XB_SPIN_CAP) { atomicAdd(&bar[XB_TMO], 1u); break; } }
    }
    nloc = mine > 0u ? mine : 1u; nx = cnt > 0u ? cnt : 1u;
}

__device__ __forceinline__ void xcd_barrier(const XcdBarrier& b) {
    asm volatile("s_waitcnt vmcnt(0)" ::: "memory");
    __syncthreads();
    if (threadIdx.x == 0) {
        unsigned* bar = b.bar;
        __builtin_amdgcn_s_waitcnt(0);
        unsigned nloc = b.st[0], nx = b.st[1];
        if (nloc == 0u) { xcd_barrier_complete(bar, b.x, nloc, nx); b.st[0] = nloc; b.st[1] = nx; }
        const unsigned old = xb_add(&bar[XB_XSUB(b.x)], 1u);
        const unsigned gen = old / nloc;
        if (old + 1u == (gen + 1u) * nloc) {
            __builtin_amdgcn_fence(__ATOMIC_RELEASE, "agent");
            asm volatile("s_waitcnt vmcnt(0)" ::: "memory");
            const unsigned og = xb_add(&bar[XB_TOP], 1u);
            const unsigned tg = og / nx;
            if (og + 1u == (tg + 1u) * nx) xb_add(&bar[XB_TOPGEN], 1u);
            else XB_SPIN(xb_ld(&bar[XB_TOPGEN]) == tg, bar);
            __builtin_amdgcn_fence(__ATOMIC_ACQUIRE, "agent");
            xb_add(&bar[XB_XGEN(b.x)], 1u);
            asm volatile("s_waitcnt vmcnt(0)" ::: "memory");
        } else {
            XB_SPIN(xb_ld(&bar[XB_XGEN(b.x)]) == gen, bar);
            __builtin_amdgcn_fence(__ATOMIC_ACQUIRE, "agent");
            asm volatile("s_waitcnt vmcnt(0)" ::: "memory");
        }
    }
    __syncthreads();
}
__device__ __forceinline__ int opaque_tid() { int t = threadIdx.x; asm volatile("" : "+v"(t)); return t; }
__device__ __forceinline__ float wave_sum(float v) {
#pragma unroll
    for (int o = 1; o < 64; o <<= 1) v += __shfl_xor(v, o);
    return v;
}
template <int CTRL> __device__ __forceinline__ float dpp_mov_(float v) { return __uint_as_float((unsigned)__builtin_amdgcn_update_dpp(0, (int)__float_as_uint(v), CTRL, 0xF, 0xF, true)); }
__device__ __forceinline__ float wave_sum_fast(float v) {
    v += dpp_mov_<0xB1>(v); v += dpp_mov_<0x4E>(v); v += dpp_mov_<0x141>(v); v += dpp_mov_<0x140>(v);
    { auto r = __builtin_amdgcn_permlane16_swap(__float_as_uint(v), __float_as_uint(v), false, false); v = __uint_as_float(r[0]) + __uint_as_float(r[1]); }
    { auto r = __builtin_amdgcn_permlane32_swap(__float_as_uint(v), __float_as_uint(v), false, false); v = __uint_as_float(r[0]) + __uint_as_float(r[1]); }
    return v;
}
__device__ __forceinline__ void p0_transpose_item(const float* W, int K, int N, bf16* WT, LAS float* scr, int item, int lane, const float* ga = nullptr, const float* gs = nullptr) {
    const int nblk = N / 32, kb = item / nblk, nb = item % nblk, k0 = 64 * kb, n0 = 32 * nb;
    float wv[32];
#pragma unroll
    for (int i = 0; i < 32; ++i) wv[i] = W[(size_t)(k0 + 2 * i + (lane >> 5)) * N + n0 + (lane & 31)];
#pragma unroll
    for (int i = 0; i < 32; ++i) { const int k = k0 + 2 * i + (lane >> 5); const float gk = ga ? (k < 1024 ? ga[k] : gs[k - 1024]) : 1.f; scr[(2 * i + (lane >> 5)) * 33 + (lane & 31)] = wv[i] * gk; }
    LDS_WAIT(); asm volatile("" ::: "memory");
    const int c = lane & 7;
#pragma unroll
    for (int j = 0; j < 4; ++j) { const int n = (lane >> 3) + 8 * j; const LAS float* s = scr + (8 * c) * 33 + n;
        v4u o; o.x = pk2(s[0 * 33], s[1 * 33]); o.y = pk2(s[2 * 33], s[3 * 33]); o.z = pk2(s[4 * 33], s[5 * 33]); o.w = pk2(s[6 * 33], s[7 * 33]);
        *(GAS v4u*)(WT + (size_t)(n0 + n) * K + k0 + 8 * c) = o; }
    LDS_WAIT(); asm volatile("" ::: "memory");
}
struct Ptrs {
    const float* in[24]; float* out; unsigned char* ws;
};

__device__ __forceinline__ void p0_weights(LAS unsigned char* lds, int gw, int ngw, int wave) {
    const int lane = opaque_tid() & 63;
    LAS float* scr = (LAS float*)(lds + RING_OFF + wave * 16384);
    constexpr int I_IN = (DM / 64) * (INW / 32), I_GLU = (SW / 64) * (SW / 32), I_OUT = (DM / 64) * (DM / 32), I_1 = (DM / 64) * (FF / 32), I_2 = (FF / 64) * (DM / 32);
    constexpr int PER_LAYER = I_IN + I_GLU + I_OUT + I_1 + I_2;
    for (int it = gw; it < DEPTH * PER_LAYER; it += ngw) {
        const int l = it / PER_LAYER; int r = it % PER_LAYER;
        if (r < I_IN) { p0_transpose_item(IN(4) + (size_t)l * DM * INW, DM, INW, (bf16*)(WSP() + WS_WIN) + (size_t)l * INW * DM, scr, r, lane); continue; } r -= I_IN;
        if (r < I_GLU) { p0_transpose_item(IN(13) + (size_t)l * SW * SW, SW, SW, (bf16*)(WSP() + WS_WGLU) + (size_t)l * SW * SW, scr, r, lane); continue; } r -= I_GLU;
        if (r < I_OUT) { p0_transpose_item(IN(17) + (size_t)l * DM * DM, DM, DM, (bf16*)(WSP() + WS_WOUT) + (size_t)l * DM * DM, scr, r, lane, IN(15) + (size_t)l * AW, IN(16) + (size_t)l * SW); continue; } r -= I_OUT;
        if (r < I_1) { p0_transpose_item(IN(20) + (size_t)l * DM * FF, DM, FF, (bf16*)(WSP() + WS_W1) + (size_t)l * FF * DM, scr, r, lane); continue; } r -= I_1;
        p0_transpose_item(IN(21) + (size_t)l * FF * DM, FF, DM, (bf16*)(WSP() + WS_W2) + (size_t)l * DM * FF, scr, r, lane);
    }
}
__device__ __forceinline__ void p0_mods(LAS unsigned char* lds, int wave) {
    const int tid = opaque_tid(), lane = tid & 63;
    LAS float* cond = (LAS float*)(lds);
    LAS float* part = (LAS float*)(lds + 32768);
    const float* c = IN(1);
    for (int i = tid; i < BATCH * DM; i += NWAVES * 64) { const float v = c[i]; cond[i] = v / (1.f + __expf(-v)); }
    __syncthreads();
    float* mods = (float*)(WSP() + WS_MODS);
    constexpr int NCH = NMOD / 128;
    for (int it = blockIdx.x; it < DEPTH * NCH; it += gridDim.x) {
        const int l = it / NCH, n0 = (it % NCH) * 128;
        const float* W = IN(2) + (size_t)l * DM * NMOD + n0 + 4 * (lane & 31);
        const int kbase = wave * 256 + (lane >> 5);
        f32x4 a0 = {0.f, 0.f, 0.f, 0.f}, a1 = a0, a2 = a0, a3 = a0;
#pragma unroll 8
        for (int i = 0; i < 128; ++i) { const int k = kbase + 2 * i; const f32x4 w = *(const f32x4*)(W + (size_t)k * NMOD);
            a0 += w * cond[k]; a1 += w * cond[DM + k]; a2 += w * cond[2 * DM + k]; a3 += w * cond[3 * DM + k]; }
        const int slot = wave * 2 + (lane >> 5), cc = 4 * (lane & 31);
        *(LAS f32x4*)(part + (slot * 4 + 0) * 128 + cc) = a0; *(LAS f32x4*)(part + (slot * 4 + 1) * 128 + cc) = a1;
        *(LAS f32x4*)(part + (slot * 4 + 2) * 128 + cc) = a2; *(LAS f32x4*)(part + (slot * 4 + 3) * 128 + cc) = a3;
        __syncthreads();
        { const int b = tid >> 7, col = tid & 127; float s = 0.f;
#pragma unroll
          for (int sl = 0; sl < 16; ++sl) s += part[(sl * 4 + b) * 128 + col];
          mods[((size_t)l * BATCH + b) * NMOD + n0 + col] = s + IN(3)[(size_t)l * NMOD + n0 + col]; }
        __syncthreads();
    }
}
__device__ __forceinline__ void row_mod_pass(const float* X, bf16* H, bf16* YB, const float* mods_l  , int sh_off, int sc_off, int gw, int ngw) {
    const int lane = opaque_tid() & 63;
    for (int r = gw; r < M; r += ngw) {
        const int b = r / SEQ; const float* mb = mods_l + (size_t)b * NMOD;
        const float* xr = X + (size_t)r * DM; bf16* hr = H + (size_t)r * DM; bf16* yr = YB + (size_t)r * DM;
#pragma unroll
        for (int j = 0; j < 8; ++j) { const int col = 4 * (64 * j + lane);
            const f32x4 v = *(const f32x4*)(xr + col), sc = *(const f32x4*)(mb + sc_off + col), sh = *(const f32x4*)(mb + sh_off + col);
            const f32x4 h = v * (sc + 1.0f) + sh;
            uint2 o; o.x = pk2(h[0], h[1]); o.y = pk2(h[2], h[3]); *(uint2*)(hr + col) = o;
            { typedef _Float16 f16x4 __attribute__((ext_vector_type(4))); const f16x4 y = {(_Float16)v[0], (_Float16)v[1], (_Float16)v[2], (_Float16)v[3]}; *(uint2*)(yr + col) = __builtin_bit_cast(uint2, y); } }
    }
}
__device__ __forceinline__ void ln_row_math(int r, int lane, const v4u (&w)[4], bf16* H, float* XO, float* stats, const float* lg, const float* lb, const float* mods_l, int sh_off, int sc_off) {
    float v[4][8]; float s = 0.f;
#pragma unroll
    for (int j = 0; j < 4; ++j) {
        { f32x4 a_, b_; pg8::unpack_f16x8(w[j], a_, b_); v[j][0] = a_[0]; v[j][1] = a_[1]; v[j][2] = a_[2]; v[j][3] = a_[3]; v[j][4] = b_[0]; v[j][5] = b_[1]; v[j][6] = b_[2]; v[j][7] = b_[3]; }
#pragma unroll
        for (int e = 0; e < 8; ++e) s += v[j][e]; }
    const float mean = wave_sum_fast(s) * (1.f / DM); float s2 = 0.f;
#pragma unroll
    for (int j = 0; j < 4; ++j)
#pragma unroll
        for (int e = 0; e < 8; ++e) { v[j][e] -= mean; s2 += v[j][e] * v[j][e]; }
    const float rstd = 1.f / sqrtf(wave_sum_fast(s2) * (1.f / DM) + LN_EPS);
    if (lane == 0) { *(float2*)(stats + 2 * (size_t)r) = make_float2(mean, rstd); }
    const int b = r / SEQ; const float* mb = mods_l ? mods_l + (size_t)b * NMOD : nullptr; bf16* hr = H + (size_t)r * DM;
#pragma unroll
    for (int j = 0; j < 4; ++j) { const int col = 8 * (64 * j + lane);
        f32x4 x[2];
#pragma unroll
        for (int q = 0; q < 2; ++q) { const f32x4 vv = {v[j][4 * q], v[j][4 * q + 1], v[j][4 * q + 2], v[j][4 * q + 3]}; x[q] = vv * rstd * *(const f32x4*)(lg + col + 4 * q) + *(const f32x4*)(lb + col + 4 * q); }
        if (XO) { *(f32x4*)(XO + (size_t)r * DM + col) = x[0]; *(f32x4*)(XO + (size_t)r * DM + col + 4) = x[1]; }
        if (mb) { f32x4 h[2];
#pragma unroll
            for (int q = 0; q < 2; ++q) h[q] = x[q] * (*(const f32x4*)(mb + sc_off + col + 4 * q) + 1.0f) + *(const f32x4*)(mb + sh_off + col + 4 * q);
            v4u o; o.x = pk2(h[0][0], h[0][1]); o.y = pk2(h[0][2], h[0][3]); o.z = pk2(h[1][0], h[1][1]); o.w = pk2(h[1][2], h[1][3]); *(v4u*)(hr + col) = o; } }
}
__device__ __forceinline__ void ln_rows4_sc1(const bf16* YB, bf16* H, float* XO, float* stats, const float* lg, const float* lb, const float* mods_l, int sh_off, int sc_off, int r0) {
    const int lane = opaque_tid() & 63;
    v4u w[4][4];
#pragma unroll
    for (int k = 0; k < 4; ++k)
#pragma unroll
        for (int j = 0; j < 4; ++j) { const bf16* p = YB + (size_t)(r0 + k) * DM + 8 * (64 * j + lane); asm volatile("global_load_dwordx4 %0, %1, off sc1" : "=&v"(w[k][j]) : "v"(p) : "memory"); }
    asm volatile("s_waitcnt vmcnt(0)" : "+v"(w[0][0]), "+v"(w[0][1]), "+v"(w[0][2]), "+v"(w[0][3]), "+v"(w[1][0]), "+v"(w[1][1]), "+v"(w[1][2]), "+v"(w[1][3]),
                                         "+v"(w[2][0]), "+v"(w[2][1]), "+v"(w[2][2]), "+v"(w[2][3]), "+v"(w[3][0]), "+v"(w[3][1]), "+v"(w[3][2]), "+v"(w[3][3]) :: "memory");
#pragma unroll
    for (int k = 0; k < 4; ++k) ln_row_math(r0 + k, lane, w[k], H, XO, stats, lg, lb, mods_l, sh_off, sc_off);
}
__device__ __forceinline__ void ln_queue_pass(LAS unsigned char* lds, int inst, const bf16* YB, bf16* H, float* XO, float* stats, const float* lg, const float* lb, const float* mods_l, int sh_off, int sc_off, int G) {
    typedef GAS unsigned gu32_;
    gu32_* q = (gu32_*)(WSP() + WS_LNQ) + inst * 64; gu32_* cnt = (gu32_*)(WSP() + WS_LNCNT) + inst * 128;
    volatile LAS unsigned* bc = (volatile LAS unsigned*)(lds + LDSCTL_OFF + 1008);
    const int tid = opaque_tid(), wave = tid >> 6;
    for (unsigned it = 0;; ++it) {
        if (tid == 0) { const unsigned hp = __hip_atomic_fetch_add(q, 1u, __ATOMIC_RELAXED, __HIP_MEMORY_SCOPE_AGENT);
            if (hp < 1024u) { const unsigned n = hp >> 3; unsigned panel = n;
                if (G == 256) { const unsigned i = n >> 5, rem = n & 31u; panel = 4u * ((rem >> 2) * 4u + i) + (rem & 3u); }
                for (unsigned spins = 0; __hip_atomic_load(cnt + panel, __ATOMIC_RELAXED, __HIP_MEMORY_SCOPE_AGENT) != 8u && spins < (1u << 24); ++spins) __builtin_amdgcn_s_sleep(4);
                bc[it & 1u] = panel * 256u + (hp & 7u) * 32u; }
            else bc[it & 1u] = 0xFFFFFFFFu; }
        __syncthreads();
        const unsigned rb = bc[it & 1u];
        if (rb == 0xFFFFFFFFu) break;
        ln_rows4_sc1(YB, H, XO, stats, lg, lb, mods_l, sh_off, sc_off, (int)rb + wave * 4);
    }
}
__device__ __forceinline__ void row_factor_pass(const float* SSQP  , float* RF  , int gtid0, int ngt) {
    const int gtid = gtid0 + opaque_tid();
    for (int r = gtid; r < M; r += ngt) {
        float sa = 0.f, ss = 0.f;
#pragma unroll
        for (int j = 0; j < 4; ++j) { const f32x4 a = *(const f32x4*)(SSQP + (size_t)r * 16 + 4 * j), s = *(const f32x4*)(SSQP + ((size_t)M + r) * 16 + 4 * j);
            sa += (a[0] + a[1]) + (a[2] + a[3]); ss += (s[0] + s[1]) + (s[2] + s[3]); }
        const float va = sa * (1.f / AW) + LN_EPS, vs = ss * (1.f / SW) + LN_EPS;
        *(float2*)(RF + 2 * (size_t)r) = make_float2(sqrtf(vs / va), 1.0f / sqrtf(vs));
    }
}
namespace at3 {
typedef short bf16x8 __attribute__((ext_vector_type(8)));
typedef short s16x4 __attribute__((ext_vector_type(4)));
typedef short v4i16_t __attribute__((ext_vector_type(4)));
typedef float f32x4 __attribute__((ext_vector_type(4)));
typedef float f32x2_t __attribute__((ext_vector_type(2))); typedef __bf16 bf16x2_t __attribute__((ext_vector_type(2)));
__device__ __forceinline__ unsigned cvtpk(float lo, float hi) { f32x2_t v = {lo, hi}; bf16x2_t b = __builtin_convertvector(v, bf16x2_t); return __builtin_bit_cast(unsigned, b); }
#define AT_LAS __attribute__((address_space(3)))
#define WG_BAR() asm volatile("s_waitcnt lgkmcnt(0)\n\ts_barrier" ::: "memory")
constexpr int NSTG = 27, NS1 = 5, NS2 = 11, NSLOT2 = 21;
constexpr int KROW = 144, KIMG = 32 * KROW, SUBI = 1056, VIMG = 4 * SUBI, WIMG = KIMG + VIMG;
constexpr int OLW = 68;
constexpr int LDS_OL = 8 * WIMG, LDS_ML = LDS_OL + 256 * OLW * 4, LDS_LL = LDS_ML + 1024, LDS_ATT_END = LDS_LL + 1024;
constexpr float QSCALE = 0.125f * 1.4426950408889634f;
constexpr float THR = 8.f;
__host__ __device__ constexpr int p2_pi(int t) { return t < 9 ? 0 : 1; }
__host__ __device__ constexpr int pi_d(int pi) { return pi == 0 ? 16 : (pi == 1 ? 4 : 1); }
__host__ __device__ constexpr int p2_mt(int t) { return t < 9 ? 16 * t : 16 * (t - 9); }
struct UnitCtx { const char* Kb; const char* Vb; const char* Qb; char* Ob; float* Sq; int T0; };
struct LaneK { unsigned voffR[3]; float jfb0[3]; int lane; };
__device__ __forceinline__ float lane_max16(float x) { auto r = __builtin_amdgcn_permlane16_swap(__float_as_uint(x), __float_as_uint(x), false, false); return fmaxf(__uint_as_float(r[0]), __uint_as_float(r[1])); }
__device__ __forceinline__ float lane_max32(float x) { auto r = __builtin_amdgcn_permlane32_swap(__float_as_uint(x), __float_as_uint(x), false, false); return fmaxf(__uint_as_float(r[0]), __uint_as_float(r[1])); }
template <int S> struct StageInfo {
    static constexpr bool P1 = S < NS1;
    static constexpr int ls = P1 ? S : (S - NS1) % NS2;
    static constexpr int setB = P1 ? 0 : (S - NS1) / NS2;
    static constexpr int slot(int hh) { return 2 * ls + hh; }
};
template <int S> __device__ __forceinline__ void issue_stage(const UnitCtx& c, int wave, const LaneK& L, v4u (&kf)[4], v4u (&vf)[4]) {
    typedef StageInfo<S> SI;
#pragma unroll
    for (int cc = 0; cc < 4; ++cc) {
        long tok; int pi;
        if constexpr (SI::P1) { pi = 2; tok = c.T0 + 32 * wave - 64 + 32 * SI::ls + 8 * cc; }
        else { const int t = (SI::slot(cc >> 1) < NSLOT2) ? SI::slot(cc >> 1) : SI::slot(0); pi = p2_pi(t); const int d = pi_d(pi);
               tok = c.T0 + 2 * wave + SI::setB - 64 * d + d * (p2_mt(t) + 8 * (cc & 1)); }
        const long off = tok * (HD * 2);
        kf[cc] = *(const v4u*)(c.Kb + off + L.voffR[pi]); vf[cc] = *(const v4u*)(c.Vb + off + L.voffR[pi]); }
}
__device__ __forceinline__ void write_images(AT_LAS unsigned char* img, int lane, const v4u (&kf)[4], const v4u (&vf)[4]) {
    AT_LAS unsigned char* kp = img + (lane >> 3) * KROW + (lane & 7) * 16;
    AT_LAS unsigned char* vp = img + KIMG + ((lane & 7) >> 1) * SUBI + (lane >> 3) * 32 + (lane & 1) * 16;
#pragma unroll
    for (int cc = 0; cc < 4; ++cc) { *(AT_LAS v4u*)(kp + cc * 8 * KROW) = kf[cc]; *(AT_LAS v4u*)(vp + cc * 256) = vf[cc]; }
}
__device__ __forceinline__ void read_kfrag(const AT_LAS unsigned char* img, int lane, bf16x8 (&ka)[4]) {
    const AT_LAS unsigned char* p = img + (lane & 15) * KROW + (lane >> 4) * 16;
#pragma unroll
    for (int hh = 0; hh < 2; ++hh) { ka[2 * hh] = *(const AT_LAS bf16x8*)(p + hh * 16 * KROW); ka[2 * hh + 1] = *(const AT_LAS bf16x8*)(p + hh * 16 * KROW + 64); }
}
__device__ __forceinline__ void read_vfrag(const AT_LAS unsigned char* img, int lane, bf16x8 (&va)[4]) {
    const AT_LAS unsigned char* vb = img + KIMG + (4 * (lane >> 4) + ((lane & 15) >> 2)) * 32 + 8 * (lane & 3);
#pragma unroll
    for (int cc = 0; cc < 4; ++cc) {
        const s16x4 lo = __builtin_bit_cast(s16x4, __builtin_amdgcn_ds_read_tr16_b64_v4i16((AT_LAS v4i16_t*)(vb + cc * SUBI)));
        const s16x4 hi = __builtin_bit_cast(s16x4, __builtin_amdgcn_ds_read_tr16_b64_v4i16((AT_LAS v4i16_t*)(vb + cc * SUBI + 512)));
        va[cc] = (bf16x8){lo[0], lo[1], lo[2], lo[3], hi[0], hi[1], hi[2], hi[3]}; }
}
__device__ __forceinline__ bf16x8 softmax_step(const bf16x8 (&ka)[4], const bf16x8 (&qf)[2], const float (&jf0)[2], const float (&jc)[2], const bool (&have)[2], const float (&bsv)[2],
                                               const float (&jlo)[2], const float (&jhi)[2], f32x4 (&oacc)[4], float& m_run, float& l_run) {
    const f32x4 z = {0.f, 0.f, 0.f, 0.f};
    float s[8];
#pragma unroll
    for (int hh = 0; hh < 2; ++hh) {
        if (have[hh]) {
            f32x4 st = __builtin_amdgcn_mfma_f32_16x16x32_bf16(ka[2 * hh], qf[0], z, 0, 0, 0); st = __builtin_amdgcn_mfma_f32_16x16x32_bf16(ka[2 * hh + 1], qf[1], st, 0, 0, 0);
#pragma unroll
            for (int e = 0; e < 4; ++e) { const float jf = jf0[hh] + (jc[hh] + (float)e); const bool valid = (jf >= jlo[hh]) && (jf <= jhi[hh]);
                s[4 * hh + e] = valid ? __builtin_fmaf(-bsv[hh], __builtin_fabsf(jf), st[e]) : -__builtin_inff(); }
        } else {
#pragma unroll
            for (int e = 0; e < 4; ++e) s[4 * hh + e] = -__builtin_inff(); } }
    float mx = fmaxf(fmaxf(fmaxf(s[0], s[1]), fmaxf(s[2], s[3])), fmaxf(fmaxf(s[4], s[5]), fmaxf(s[6], s[7])));
    mx = lane_max16(mx); mx = lane_max32(mx);
    if (__any(mx > m_run + THR)) {
        const float mn = fmaxf(m_run, mx), alpha = __builtin_amdgcn_exp2f(m_run - mn); m_run = mn; l_run *= alpha;
#pragma unroll
        for (int cc = 0; cc < 4; ++cc) oacc[cc] = oacc[cc] * alpha; }
    float p[8]; float ps = 0.f;
#pragma unroll
    for (int k = 0; k < 8; ++k) { p[k] = __builtin_amdgcn_exp2f(s[k] - m_run); ps += p[k]; }
    l_run += ps;
    unsigned pw[4] = {cvtpk(p[0], p[1]), cvtpk(p[2], p[3]), cvtpk(p[4], p[5]), cvtpk(p[6], p[7])};
    return __builtin_bit_cast(bf16x8, *(const v4u*)pw);
}
struct WaveState {
    bf16x8 q1[2][2], q2[2], qn[2];
    f32x4 o1[2][4], o2[4]; float m1[2], l1[2], m2, l2;
    float jlo1[2], jhi1[2], jlo2[2], jhi2[2];
};
__device__ __forceinline__ void load_q(const char* Qb, long tok0, int stride, int lane_, bf16x8 (&qf)[2]) {
    const int lane = opaque_tid() & 63; (void)lane_;
    const char* qp = Qb + ((tok0 + (long)stride * (lane & 15)) * AW + 8 * (lane >> 4)) * 2; qf[0] = *(const bf16x8*)qp; qf[1] = *(const bf16x8*)(qp + 64); }
template <int S> __device__ __forceinline__ void compute_stage(const UnitCtx& c, int wave, const LaneK& L, const float (&bs)[3], AT_LAS unsigned char* lds, AT_LAS unsigned char* img,
                                                               const v4u (&kf)[4], const v4u (&vf)[4], WaveState& W) {
    typedef StageInfo<S> SI;
    const int lane = L.lane, n = lane & 15, g = lane >> 4;
    write_images(img, lane, kf, vf);
    bf16x8 ka[4], va[4];
    read_kfrag(img, lane, ka);
    if constexpr (SI::P1) {
        bf16x8 pb[2];
#pragma unroll
        for (int s2 = 0; s2 < 2; ++s2) {
            const float jf0[2] = {L.jfb0[2], L.jfb0[2]}, jc[2] = {(float)(32 * SI::ls - 16 * s2), (float)(32 * SI::ls + 16 - 16 * s2)}; const bool have[2] = {true, true};
            const float bsv[2] = {bs[2], bs[2]}, jlo[2] = {W.jlo1[s2], W.jlo1[s2]}, jhi[2] = {W.jhi1[s2], W.jhi1[s2]};
            pb[s2] = softmax_step(ka, W.q1[s2], jf0, jc, have, bsv, jlo, jhi, W.o1[s2], W.m1[s2], W.l1[s2]); }
        read_vfrag(img, lane, va);
#pragma unroll
        for (int s2 = 0; s2 < 2; ++s2)
#pragma unroll
            for (int cc = 0; cc < 4; ++cc) W.o1[s2][cc] = __builtin_amdgcn_mfma_f32_16x16x32_bf16(va[cc], pb[s2], W.o1[s2][cc], 0, 0, 0);
    } else {
        constexpr int t0 = SI::slot(0), t1 = SI::slot(1); constexpr bool h1 = t1 < NSLOT2; constexpr int t1c = h1 ? t1 : t0;
        constexpr int p0 = p2_pi(t0), p1 = p2_pi(t1c);
        const float jf0[2] = {L.jfb0[p0], L.jfb0[p1]}, jc[2] = {(float)p2_mt(t0), (float)p2_mt(t1c)}; const bool have[2] = {true, h1};
        const float bsv[2] = {bs[p0], bs[p1]}, jlo[2] = {W.jlo2[p0], W.jlo2[p1]}, jhi[2] = {W.jhi2[p0], W.jhi2[p1]};
        const bf16x8 pb = softmax_step(ka, W.q2, jf0, jc, have, bsv, jlo, jhi, W.o2, W.m2, W.l2);
        read_vfrag(img, lane, va);
#pragma unroll
        for (int cc = 0; cc < 4; ++cc) W.o2[cc] = __builtin_amdgcn_mfma_f32_16x16x32_bf16(va[cc], pb, W.o2[cc], 0, 0, 0);
    }
}
__device__ __forceinline__ void jwin(int tq, int sh, float& lo, float& hi) { const int a = -(tq >> sh), b = (SEQ - 1 - tq) >> sh; lo = (float)(a < -64 ? -64 : a); hi = (float)(b > 64 ? 64 : b); }
__device__ __forceinline__ void begin_pass1(const UnitCtx& c, int wave, const LaneK& L, WaveState& W) {
    const int n = opaque_tid() & 15;
#pragma unroll
    for (int s2 = 0; s2 < 2; ++s2) { W.m1[s2] = -1e30f; W.l1[s2] = 0.f; jwin(c.T0 + 32 * wave + 16 * s2 + n, 0, W.jlo1[s2], W.jhi1[s2]);
#pragma unroll
        for (int cc = 0; cc < 4; ++cc) W.o1[s2][cc] = (f32x4){0.f, 0.f, 0.f, 0.f}; }
}
__device__ __forceinline__ void end_pass1(int wave, const LaneK& L, AT_LAS unsigned char* lds, WaveState& W) {
    const int ln_ = opaque_tid() & 63, n = ln_ & 15, g = ln_ >> 4;
#pragma unroll
    for (int s2 = 0; s2 < 2; ++s2) { const int q = 32 * wave + 16 * s2 + n;
        float lt = W.l1[s2]; lt = fsum_x16x32(lt);
#pragma unroll
        for (int cc = 0; cc < 4; ++cc) *(AT_LAS f32x4*)(lds + LDS_OL + (q * OLW + 16 * cc + 4 * g) * 4) = W.o1[s2][cc];
        if (g == 0) { *(AT_LAS float*)(lds + LDS_ML + 4 * q) = W.m1[s2]; *(AT_LAS float*)(lds + LDS_LL + 4 * q) = lt; } }
}
__device__ __forceinline__ void begin_pass2(const UnitCtx& c, int r, const LaneK& L, AT_LAS unsigned char* lds, WaveState& W) {
    const int ln_ = opaque_tid() & 63, n = ln_ & 15, g = ln_ >> 4, q = r + 16 * n;
#pragma unroll
    for (int cc = 0; cc < 4; ++cc) W.o2[cc] = *(const AT_LAS f32x4*)(lds + LDS_OL + (q * OLW + 16 * cc + 4 * g) * 4);
    W.m2 = *(const AT_LAS float*)(lds + LDS_ML + 4 * q); const float lq = *(const AT_LAS float*)(lds + LDS_LL + 4 * q); W.l2 = (g == 0) ? lq : 0.f;
    jwin(c.T0 + q, 4, W.jlo2[0], W.jhi2[0]); jwin(c.T0 + q, 2, W.jlo2[1], W.jhi2[1]);
}
__device__ __forceinline__ void end_pass2(const UnitCtx& c, int r, const LaneK& L, WaveState& W) {
    const int ln_ = opaque_tid() & 63, n = ln_ & 15, g = ln_ >> 4;
    float lt = W.l2; lt = fsum_x16x32(lt);
    const float inv = 1.f / lt;
    char* op = c.Ob + ((long)(c.T0 + r + 16 * n) * DM + 4 * g) * 2;
    float sq = 0.f;
#pragma unroll
    for (int cc = 0; cc < 4; ++cc) { const f32x4 o = W.o2[cc] * inv; sq += (o[0] * o[0] + o[1] * o[1]) + (o[2] * o[2] + o[3] * o[3]);
        uint2 w; w.x = cvtpk(o[0], o[1]); w.y = cvtpk(o[2], o[3]); *(uint2*)(op + 32 * cc) = w; }
    sq = fsum_x16x32(sq);
    if (g == 0) c.Sq[(size_t)(c.T0 + r + 16 * n) * 16] = sq;
}
template <int S> struct StageLoop {
    static __device__ __forceinline__ void run(const UnitCtx& cur, const UnitCtx& nxt, int wave, const LaneK& L, const float (&bs)[3], AT_LAS unsigned char* lds, AT_LAS unsigned char* img,
                                               v4u (&kf)[3][4], v4u (&vf)[3][4], WaveState& W) {
        constexpr int T = S + 2;
        if constexpr (T < NSTG) issue_stage<T>(cur, wave, L, kf[T % 3], vf[T % 3]);
        else issue_stage<T - NSTG>(nxt, wave, L, kf[T % 3], vf[T % 3]);
        if constexpr (S == NS1 - 3) load_q(cur.Qb, cur.T0 + 2 * wave, 16, L.lane, W.q2);
        if constexpr (S == NS1 + NS2 - 3) load_q(cur.Qb, cur.T0 + 2 * wave + 1, 16, L.lane, W.qn);
        if constexpr (S == NSTG - 3) { load_q(nxt.Qb, nxt.T0 + 32 * wave, 1, L.lane, W.q1[0]); load_q(nxt.Qb, nxt.T0 + 32 * wave + 16, 1, L.lane, W.q1[1]); }
        __builtin_amdgcn_sched_barrier(0);
        if constexpr (S == 0) begin_pass1(cur, wave, L, W);
        if constexpr (S == NS1) { end_pass1(wave, L, lds, W); WG_BAR(); begin_pass2(cur, 2 * wave, L, lds, W); }
        if constexpr (S == NS1 + NS2) { end_pass2(cur, 2 * wave, L, W); W.q2[0] = W.qn[0]; W.q2[1] = W.qn[1]; begin_pass2(cur, 2 * wave + 1, L, lds, W); WG_BAR(); }
        compute_stage<S>(cur, wave, L, bs, lds, img, kf[S % 3], vf[S % 3], W);
        if constexpr (S == NSTG - 1) end_pass2(cur, 2 * wave + 1, L, W);
        __builtin_amdgcn_sched_barrier(0);
        StageLoop<S + 1>::run(cur, nxt, wave, L, bs, lds, img, kf, vf, W);
    }
};
template <> struct StageLoop<NSTG> { static __device__ __forceinline__ void run(const UnitCtx&, const UnitCtx&, int, const LaneK&, const float (&)[3], AT_LAS unsigned char*, AT_LAS unsigned char*, v4u (&)[3][4], v4u (&)[3][4], WaveState&) {} };
__device__ __forceinline__ UnitCtx make_ctx(const bf16* Q, const bf16* K, const bf16* V, bf16* O, float* SSQ, int u) {
    const int sb = u & 31, h = (u >> 5) & 15, b = u >> 9; const size_t rb = (size_t)b * SEQ;
    UnitCtx c; c.Kb = (const char*)(K + ((size_t)h * M + rb) * HD); c.Vb = (const char*)(V + ((size_t)h * M + rb) * HD);
    c.Qb = (const char*)(Q + rb * AW + h * HD); c.Ob = (char*)(O + rb * DM + h * HD); c.Sq = SSQ + rb * 16 + h; c.T0 = sb * 256; return c;
}
__device__ __forceinline__ void attn_phase(const bf16* Q, const bf16* K, const bf16* V, bf16* O  , float* SSQ, AT_LAS unsigned char* lds, int vcu, int G, int wave) {
    LaneK L; L.lane = opaque_tid() & 63;
    const int lane = L.lane, n = lane & 15, g = lane >> 4;
#pragma unroll
    for (int pi = 0; pi < 3; ++pi) { const int d = pi_d(pi); L.voffR[pi] = (unsigned)(d * (lane >> 3) * HD + 8 * (lane & 7)) * 2u; L.jfb0[pi] = (float)(4 * g - 64 - (pi == 2 ? 1 : 16 / d) * n); }
    AT_LAS unsigned char* img = lds + wave * WIMG;
    const int NU = BATCH * NH * (SEQ / 256);
    if (vcu >= NU) return;
    UnitCtx cur = make_ctx(Q, K, V, O, SSQ, vcu);
    v4u kf[3][4], vf[3][4]; WaveState W;
    load_q(cur.Qb, cur.T0 + 32 * wave, 1, lane, W.q1[0]); load_q(cur.Qb, cur.T0 + 32 * wave + 16, 1, lane, W.q1[1]);
    issue_stage<0>(cur, wave, L, kf[0], vf[0]); issue_stage<1>(cur, wave, L, kf[1], vf[1]);
#pragma unroll 1
    for (int k = 0;; ++k) {
        asm volatile("" : "+v"(L.jfb0[0]), "+v"(L.jfb0[1]), "+v"(L.jfb0[2]));
        const int un = vcu + G * (k + 1); const bool has_next = un < NU;
        const UnitCtx nxt = has_next ? make_ctx(Q, K, V, O, SSQ, un) : cur;
        const int h = ((vcu + G * k) >> 5) & 15;
        const float slope2 = exp2f(-0.5f * (float)(h + 1)) * 1.4426950408889634f;
        const float bs[3] = {slope2 * 16.f, slope2 * 4.f, slope2};
        StageLoop<0>::run(cur, nxt, wave, L, bs, lds, img, kf, vf, W);
        if (!has_next) break;
        cur = nxt;
    }
}
}


constexpr int CH = 32, NCHUNK = M / CH  , CPS = SEQ / CH  , KX = 768;
constexpr int T_PW = 0;
constexpr int T_BB = 8192;
constexpr int T_CC = 12288;
constexpr int T_KT = 16384;
typedef float f32x2v __attribute__((ext_vector_type(2)));
__device__ __forceinline__ f32x2v cmul(f32x2v a, f32x2v b) { return (f32x2v){a.x * b.x - a.y * b.y, a.x * b.y + a.y * b.x}; }
__device__ __forceinline__ void ssm_prep_item(int l, int g, LAS unsigned char* lds, bf16* BST  , bf16* WY  ) {
    const int tid = opaque_tid();
    LAS float* T = (LAS float*)lds;
    LAS f32x2v* PW = (LAS f32x2v*)(T + T_PW); LAS f32x2v* BB = (LAS f32x2v*)(T + T_BB); LAS f32x2v* CC = (LAS f32x2v*)(T + T_CC); LAS float* KT = T + T_KT;
    {
#pragma unroll 1
        for (int k = 0; k < 4; ++k) { const int idx = tid + 512 * k; const int dir = idx >> 10, p = (idx >> 4) & 63, c = idx & 15;
            const size_t gi = ((size_t)l * 2 + dir) * NG + g;
            const float step = __expf(IN(7)[gi]); const float lr = IN(5)[gi * SP + p], li = IN(6)[gi * SP + p];
            const float mag = __expf(lr * step); float sn, cs; sincosf(li * step, &sn, &cs);
            const float a_re = mag * cs, a_im = mag * sn, den = lr * lr + li * li;
            const float cf_re = ((a_re - 1.f) * lr + a_im * li) / den, cf_im = (a_im * lr - (a_re - 1.f) * li) / den;
            const float br = IN(8)[(gi * SP + p) * SG + c], bi = IN(9)[(gi * SP + p) * SG + c];
            BB[(dir * 64 + p) * 16 + c] = (f32x2v){cf_re * br - cf_im * bi, cf_re * bi + cf_im * br};
            const int co = (idx >> 6) & 15, pp = idx & 63;
            CC[idx] = (f32x2v){IN(10)[(gi * SG + co) * SP + pp], IN(11)[(gi * SG + co) * SP + pp]}; }
        if (tid < 128) { const int dir = tid >> 6, p = tid & 63; const size_t gi = ((size_t)l * 2 + dir) * NG + g;
            const float step = __expf(IN(7)[gi]); const float lr = IN(5)[gi * SP + p], li = IN(6)[gi * SP + p];
#pragma unroll 1
            for (int e = 1; e <= 32; ++e) { const float mag = __expf(lr * step * (float)e); float sn, cs; sincosf(li * step * (float)e, &sn, &cs);
                PW[(dir * 32 + (e - 1)) * 64 + p] = (f32x2v){mag * cs, mag * sn}; } }
    }
    __syncthreads();
#define PWR_(dir, e, p) ((e) == 0 ? (f32x2v){1.f, 0.f} : PW[((dir) * 32 + ((e) > 0 ? (e) - 1 : 0)) * 64 + (p)])
    {   const int dir = tid >> 8, co = (tid >> 4) & 15, ci = tid & 15;
        float acc[32];
#pragma unroll
        for (int i = 0; i < 32; ++i) acc[i] = 0.f;
#pragma unroll 1
        for (int p = 0; p < 64; ++p) { const f32x2v w = cmul(CC[(dir * 16 + co) * 64 + p], BB[(dir * 64 + p) * 16 + ci]);
            acc[0] += w.x;
#pragma unroll
            for (int lag = 1; lag < 32; ++lag) { const f32x2v pw = PW[(dir * 32 + lag - 1) * 64 + p]; acc[lag] += w.x * pw.x - w.y * pw.y; } }
#pragma unroll
        for (int lag = 0; lag < 32; ++lag) KT[(dir * 32 + lag) * 256 + co * 16 + ci] = acc[lag];
    }
    __syncthreads();
    {   bf16* W = WY + (size_t)g * 512 * KX; const float* Dk = IN(12) + (size_t)l * SW + g * SG;
#pragma unroll 1
        for (int v = tid; v < 512 * 96; v += NWAVES * 64) { const int n = v / 96, kv = v % 96, i = n >> 4, co = n & 15, k0 = 8 * kv;
            float val[8];
            if (k0 < 512) { const int j = k0 >> 4, ci0 = k0 & 15;
                if (j < i) {
#pragma unroll
                    for (int e = 0; e < 8; ++e) val[e] = KT[(0 * 32 + (i - j)) * 256 + co * 16 + ci0 + e];
                } else if (j > i) {
#pragma unroll
                    for (int e = 0; e < 8; ++e) val[e] = KT[(1 * 32 + (j - i)) * 256 + co * 16 + ci0 + e];
                } else { const float dsk = Dk[co];
#pragma unroll
                    for (int e = 0; e < 8; ++e) val[e] = KT[co * 16 + ci0 + e] + KT[32 * 256 + co * 16 + ci0 + e] + ((ci0 + e == co) ? dsk : 0.f); }
            } else { const int q = k0 - 512, dir = q >> 7, comp = (q >> 6) & 1, p0 = q & 63; const int e_ = dir == 0 ? i + 1 : 32 - i;
#pragma unroll
                for (int e = 0; e < 8; ++e) { const f32x2v z = cmul(CC[(dir * 16 + co) * 64 + p0 + e], PW[(dir * 32 + e_ - 1) * 64 + p0 + e]); val[e] = comp == 0 ? z.x : -z.y; } }
            v4u o; o.x = pk2(val[0], val[1]); o.y = pk2(val[2], val[3]); o.z = pk2(val[4], val[5]); o.w = pk2(val[6], val[7]);
            *(v4u*)(W + (size_t)n * KX + k0) = o; }
    }
    {   bf16* B = BST + (size_t)g * 256 * 512;
#pragma unroll 1
        for (int v = tid; v < 256 * 64; v += NWAVES * 64) { const int n = v >> 6, kv = v & 63, dir = n >> 7, comp = (n >> 6) & 1, p = n & 63, j = kv >> 1, ci0 = (kv & 1) * 8;
            const int e_ = dir == 0 ? 31 - j : j; const f32x2v pw = PWR_(dir, e_, p);
            float val[8];
#pragma unroll
            for (int e = 0; e < 8; ++e) { const f32x2v z = cmul(pw, BB[(dir * 64 + p) * 16 + ci0 + e]); val[e] = comp == 0 ? z.x : z.y; }
            v4u o; o.x = pk2(val[0], val[1]); o.y = pk2(val[2], val[3]); o.z = pk2(val[4], val[5]); o.w = pk2(val[6], val[7]);
            *(v4u*)(B + (size_t)n * 512 + 8 * kv) = o; }
    }
#undef PWR_
    __syncthreads();
}
__device__ __forceinline__ void ssm_scan_coop(int l, const float* S  , bf16* UX  , LAS unsigned char* lds, int vcu, int G, int wave) {
    const int lane = opaque_tid() & 63;
    const int seg = wave & 3, slot = wave >> 2;
    LAS float* T = (LAS float*)lds;
    for (int it0 = vcu; it0 < NG * BATCH * 2; it0 += 2 * G) {
        const int it = it0 + slot * G; const bool act = it < NG * BATCH * 2;
        const int itc = act ? it : it0;
        const int dir = itc & 1, b = (itc >> 1) & 3, g = itc >> 3;
        const size_t gi = ((size_t)l * 2 + dir) * NG + g;
        const float step = __expf(IN(7)[gi]); const float lr = IN(5)[gi * SP + lane], li = IN(6)[gi * SP + lane];
        float sn, cs; const float mag = __expf(lr * step * (float)CH); sincosf(li * step * (float)CH, &sn, &cs);
        const float ar = mag * cs, ai = mag * sn;
        const float magS = __expf(lr * step * (float)(CH * 64)); float snS, csS; sincosf(li * step * (float)(CH * 64), &snS, &csS);
        const float Ar = magS * csS, Ai = magS * snS;
        const size_t row0 = (size_t)g * NCHUNK + (size_t)b * CPS;
        const float* Sp = S + row0 * 256 + dir * 128 + lane; bf16* Xp = UX + row0 * KX + 512 + dir * 128 + lane;
        float sr[64], si[64];
#pragma unroll
        for (int k = 0; k < 64; ++k) { const int cc = 64 * seg + k, c = dir ? (CPS - 1 - cc) : cc; sr[k] = Sp[(size_t)c * 256]; si[k] = Sp[(size_t)c * 256 + 64]; }
        float er = 0.f, ei = 0.f;
#pragma unroll
        for (int k = 0; k < 64; ++k) { const float nr = ar * er - ai * ei + sr[k], ni = ar * ei + ai * er + si[k]; er = nr; ei = ni; }
        T[((slot * 4 + seg) * 2 + 0) * 64 + lane] = er; T[((slot * 4 + seg) * 2 + 1) * 64 + lane] = ei;
        __syncthreads();
        er = 0.f; ei = 0.f;
        for (int q = 0; q < seg; ++q) { const float tr = T[((slot * 4 + q) * 2 + 0) * 64 + lane], ti = T[((slot * 4 + q) * 2 + 1) * 64 + lane];
            const float nr = Ar * er - Ai * ei + tr, ni = Ar * ei + Ai * er + ti; er = nr; ei = ni; }
        if (act) {
#pragma unroll
            for (int k = 0; k < 64; ++k) { const int cc = 64 * seg + k, c = dir ? (CPS - 1 - cc) : cc;
                Xp[(size_t)c * KX] = (bf16)f2bf(er); Xp[(size_t)c * KX + 64] = (bf16)f2bf(ei);
                const float nr = ar * er - ai * ei + sr[k], ni = ar * ei + ai * er + si[k]; er = nr; ei = ni; } }
        __syncthreads();
    }
}

__global__ void __launch_bounds__(NWAVES * 64, 2) mega_fwd(Ptrs P_unused) {
    extern __shared__ __attribute__((aligned(16))) unsigned char lds_raw[];
    LAS unsigned char* lds = (LAS unsigned char*)lds_raw;
    const int tid = threadIdx.x, wave = __builtin_amdgcn_readfirstlane(tid >> 6);
    const int G = gridDim.x;
    const int vcu = (G % 8 == 0) ? ((int)blockIdx.x % 8) * (G / 8) + (int)blockIdx.x / 8 : (int)blockIdx.x;
    const int gw = vcu * NWAVES + wave, ngw = G * NWAVES;
    for (int u = tid; u < (LDS_BYTES - LDSCTL_OFF) / 4; u += NWAVES * 64) ((LAS unsigned*)(lds + LDSCTL_OFF))[u] = 0u;
    __syncthreads();
    (void)xcd_barrier_post(WSB(unsigned, WS_CTL) + CW_BAR, (volatile LAS unsigned*)(lds + MISC_OFF) + 8);
#define GRID_BAR() do { XcdBarrier b_; b_.bar = WSB(unsigned, WS_CTL) + CW_BAR; b_.x = xb_xcc_id(); b_.st = (volatile LAS unsigned*)(lds + MISC_OFF) + 8; xcd_barrier(b_); } while (0)

    if (tid == 0) { typedef GAS unsigned gu32_; gu32_* xc = (gu32_*)(WSP() + WS_XCHK) + 2 * ((int)blockIdx.x % 8); const unsigned id = xb_xcc_id();
        __hip_atomic_fetch_max(xc, id + 1u, __ATOMIC_RELAXED, __HIP_MEMORY_SCOPE_AGENT); __hip_atomic_fetch_max(xc + 1, 16u - id, __ATOMIC_RELAXED, __HIP_MEMORY_SCOPE_AGENT); }
    p0_mods(lds, wave);
    __syncthreads();
    p0_weights(lds, gw, ngw, wave);
    __syncthreads();
    for (int it = vcu; it < DEPTH * NG; it += G) ssm_prep_item(it / NG, it % NG, lds, WSB(bf16, WS_BST) + (size_t)(it / NG) * NG * 256 * 512, WSB(bf16, WS_WY) + (size_t)(it / NG) * NG * 512 * KX);
    GRID_BAR();
    if (tid == 0) { typedef GAS unsigned gu32_; const gu32_* xc = (const gu32_*)(WSP() + WS_XCHK); unsigned ok = (G % 8 == 0) ? 1u : 0u;
        for (int r = 0; r < 8; ++r) ok &= (__hip_atomic_load(xc + 2 * r, __ATOMIC_RELAXED, __HIP_MEMORY_SCOPE_AGENT) + __hip_atomic_load(xc + 2 * r + 1, __ATOMIC_RELAXED, __HIP_MEMORY_SCOPE_AGENT) == 17u) ? 1u : 0u;
        ((volatile LAS unsigned*)(lds + LDSCTL_OFF + 996))[0] = ok; }
    __syncthreads();
    row_mod_pass(IN(0), WSB(bf16, WS_H), WSB(bf16, WS_YB), WSB(float, WS_MODS), 0 * DM, 1 * DM, gw, ngw);
    GRID_BAR();

#pragma unroll 1
    for (int l = 0; l < DEPTH; ++l) {
        { pg8::Gemm g = pg8::gemm_rm(WSB(bf16, WS_H), WSB(bf16, WS_WIN) + (size_t)l * INW * DM, DM); pg8::StaticOrder S; S.init(M, INW, G, (int)blockIdx.x);
          pg8::EpiQKVU E{WSB(bf16, WS_QKV), (size_t)M * AW, at3::QSCALE, WSB(bf16, WS_UX), NCHUNK};
          pg8::gemm_phase<pg8::EpiQKVU, pg8::StaticOrder, true, true>(lds + RING_OFF, g, S, E); }
        GRID_BAR();
        { pg8::Gemm g{WSB(bf16, WS_UX), WSB(bf16, WS_BST) + (size_t)l * NG * 256 * 512, 512, KX, 16, 512}; pg8::GroupOrder S; S.init(NG, 4, 1, G, vcu);
          pg8::EpiStateF32 E{WSB(float, WS_S)};
          pg8::gemm_phase<pg8::EpiStateF32, pg8::GroupOrder, true, true>(lds + RING_OFF, g, S, E); }
        GRID_BAR();
        ssm_scan_coop(l, WSB(float, WS_S), WSB(bf16, WS_UX), lds + RING_OFF, vcu, G, wave);
        __syncthreads();
        at3::attn_phase(WSB(bf16, WS_QKV), WSB(bf16, WS_QKV) + (size_t)M * AW, WSB(bf16, WS_QKV) + (size_t)2 * M * AW, WSB(bf16, WS_MRG), WSB(float, WS_SSQP), lds + RING_OFF, vcu, G, wave);
        GRID_BAR();
        { pg8::Gemm g{WSB(bf16, WS_UX), WSB(bf16, WS_WY) + (size_t)l * NG * 512 * KX, KX, KX, 16, KX}; pg8::GroupOrder S; S.init(NG, 4, 2, G, vcu);
          pg8::EpiSsmY E{WSB(bf16, WS_YACT)};
          pg8::gemm_phase<pg8::EpiSsmY, pg8::GroupOrder, true, true>(lds + RING_OFF, g, S, E); }
        GRID_BAR();
        { pg8::Gemm g{WSB(bf16, WS_YACT), WSB(bf16, WS_WGLU) + (size_t)l * SW * SW, SW, 16, M * 16, SW}; pg8::StaticOrder S; S.init(M, SW, G, (int)blockIdx.x);
          pg8::EpiGluG E{WSB(bf16, WS_YACT), (size_t)M * 16, WSB(bf16, WS_MRG), DM, AW, IN(14) + (size_t)l * SW, WSB(float, WS_SSQP) + (size_t)M * 16};
          pg8::gemm_phase<pg8::EpiGluG, pg8::StaticOrder, true, true>(lds + RING_OFF, g, S, E); }
        GRID_BAR();
        row_factor_pass(WSB(float, WS_SSQP), WSB(float, WS_RF), vcu * NWAVES * 64, G * NWAVES * 64);
        GRID_BAR();
        { pg8::Gemm g = pg8::gemm_rm(WSB(bf16, WS_MRG), WSB(bf16, WS_WOUT) + (size_t)l * DM * DM, DM); pg8::StaticOrder S; S.init(M, DM, G, (int)blockIdx.x);
          pg8::EpiResidT<true> E{l, 0, WS_MODS, WS_STATS, WS_YB, WS_RF, DM, NMOD, SEQ, ALPHA, WS_LNCNT};
          pg8::gemm_phase<pg8::EpiResidT<true>, pg8::StaticOrder, true, true>(lds + RING_OFF, g, S, E); }
        ln_queue_pass(lds, l * 2, WSB(bf16, WS_YB), WSB(bf16, WS_H), nullptr, WSB(float, WS_STATS), IN(18) + (size_t)l * DM, IN(19) + (size_t)l * DM, WSB(float, WS_MODS) + (size_t)l * BATCH * NMOD, 3 * DM, 4 * DM, G);
        GRID_BAR();
        { pg8::Gemm g = pg8::gemm_rm(WSB(bf16, WS_H), WSB(bf16, WS_W1) + (size_t)l * FF * DM, DM); pg8::StaticOrder S; S.init(M, FF, G, (int)blockIdx.x);
          pg8::EpiBf16<2, true> E{WSB(bf16, WS_HID), FF, 0, 0, 1.f, WS_HIDCNT + (size_t)l * 512};
          pg8::gemm_phase<pg8::EpiBf16<2, true>, pg8::StaticOrder, true, true>(lds + RING_OFF, g, S, E); }
        if (((volatile LAS unsigned*)(lds + LDSCTL_OFF + 996))[0] == 0u) GRID_BAR();
        { pg8::Gemm g = pg8::gemm_rm(WSB(bf16, WS_HID), WSB(bf16, WS_W2) + (size_t)l * DM * FF, FF); pg8::StaticOrderDep S; S.init(M, DM, G, (int)blockIdx.x); S.cnt_off = WS_HIDCNT + (size_t)l * 512; S.need = FF / 256;
          pg8::EpiResidT<false> E{l, 1, WS_MODS, WS_STATS, WS_YB, WS_RF, DM, NMOD, SEQ, ALPHA, WS_LNCNT};
          pg8::gemm_phase<pg8::EpiResidT<false>, pg8::StaticOrderDep, true, true>(lds + RING_OFF, g, S, E); }
        ln_queue_pass(lds, l * 2 + 1, WSB(bf16, WS_YB), WSB(bf16, WS_H), (l + 1 == DEPTH) ? OUTP() : nullptr, WSB(float, WS_STATS), IN(22) + (size_t)l * DM, IN(23) + (size_t)l * DM, (l + 1 < DEPTH) ? WSB(float, WS_MODS) + (size_t)(l + 1) * BATCH * NMOD : nullptr, 0 * DM, 1 * DM, G);
        if (l + 1 < DEPTH) GRID_BAR();
    }
}

extern "C" void kernel_launch(void* const* d_in, const int* in_sizes, int n_in, void* d_out, int out_size, void* d_ws, size_t ws_size, hipStream_t stream) {
    static int grid = 0;
    if (grid == 0) {
        if (n_in != 24 || out_size != M * DM || ws_size < WS_END) { fprintf(stderr, "kernel_launch: unexpected shapes (n_in %d out %d ws %zu)\n", n_in, out_size, ws_size); grid = -1; return; }
        int dev = 0, cus = 0, per_cu = 0;
        if (hipGetDevice(&dev) != hipSuccess || hipDeviceGetAttribute(&cus, hipDeviceAttributeMultiprocessorCount, dev) != hipSuccess) { grid = -1; return; }
        if (hipFuncSetAttribute((const void*)mega_fwd, hipFuncAttributeMaxDynamicSharedMemorySize, LDS_BYTES) != hipSuccess) { fprintf(stderr, "kernel_launch: hipFuncSetAttribute failed\n"); grid = -1; return; }
        if (hipOccupancyMaxActiveBlocksPerMultiprocessor(&per_cu, (const void*)mega_fwd, NWAVES * 64, LDS_BYTES) != hipSuccess || per_cu < 1)
            fprintf(stderr, "kernel_launch: note: occupancy query reports %d workgroups per CU\n", per_cu);
        (void)hipGetLastError();
        grid = cus;
    }
    if (grid < 0) return;
    if (hipMemsetAsync((char*)d_ws + WS_CTL, 0, CTL_ZERO_BYTES, stream) != hipSuccess) return;
    Ptrs p{};
    for (int i = 0; i < 24; ++i) p.in[i] = (const float*)d_in[i];
    p.out = (float*)d_out; p.ws = (unsigned char*)d_ws;
    hipLaunchKernelGGL(mega_fwd, dim3(grid), dim3(NWAVES * 64), LDS_BYTES, stream, p);
}
```
